# Optimizing an MI355X kernel written in HIP

```python
import math
import jax, jax.numpy as jnp
from jax import lax
import numpy as np

D_MODEL = 1024
BATCH = 16
SEQ = 2048
DEPTH = 2

HEAD_DIM = 64
A_HEADS = 4
B_HEADS = 6
C_Q_HEADS = 6
C_KV_HEADS = 2
C_GROUP = C_Q_HEADS // C_KV_HEADS
A_W = A_HEADS * HEAD_DIM
B_W = B_HEADS * HEAD_DIM
C_W = C_Q_HEADS * HEAD_DIM
C_KV_W = C_KV_HEADS * HEAD_DIM
Q_BLOCK = 128
BAND_BLOCK = 128
SWA_WINDOW = 128
DILATED_PATTERNS = ((128, 1), (512, 4), (2048, 16))
ROPE_THETA = 10000.0
RMS_EPS = 1e-6
SPLIT_SIZES = (A_W, A_W, A_W, A_HEADS, A_W,
               B_W, B_W, B_W, B_W,
               C_W, C_KV_W, C_KV_W, C_W,
               D_MODEL, D_MODEL, D_MODEL)
IN_COLS = sum(SPLIT_SIZES)

kernel_name = "hybrid_fox_dilated_swa_gated_block"


def rmsnorm(x, g):
    xf = x.astype(jnp.float32)
    y = xf * lax.rsqrt(jnp.mean(xf * xf, axis=-1, keepdims=True) + RMS_EPS)
    return (y * g.astype(jnp.float32)).astype(x.dtype)


def rope_tables(seq):
    pos = jnp.arange(seq, dtype=jnp.float32)
    inv = ROPE_THETA ** (-jnp.arange(0, HEAD_DIM, 2, dtype=jnp.float32) / HEAD_DIM)
    ang = pos[:, None] * inv[None, :]
    return jnp.cos(ang), jnp.sin(ang)


def apply_rope(x, cos, sin):
    xf = x.astype(jnp.float32)
    x1, x2 = xf[..., :HEAD_DIM // 2], xf[..., HEAD_DIM // 2:]
    c, s = cos[None, :, None, :], sin[None, :, None, :]
    return jnp.concatenate([x1 * c - x2 * s, x2 * c + x1 * s], axis=-1).astype(x.dtype)


def banded_attention(q, k, v, max_dist, sink=None):
    n, seq_len, hkv, grp, hd = q.shape
    blk = BAND_BLOCK
    nb = -(-seq_len // blk)
    lp = nb * blk
    pad = lp - seq_len
    qb = jnp.pad(q, ((0, 0), (0, pad), (0, 0), (0, 0), (0, 0))).reshape(n, nb, blk, hkv, grp, hd)

    def key_blocks(t):
        tp = jnp.pad(t, ((0, 0), (blk, pad), (0, 0), (0, 0)))
        prev = tp[:, :lp].reshape(n, nb, blk, hkv, hd)
        cur = tp[:, blk:].reshape(n, nb, blk, hkv, hd)
        return jnp.concatenate([prev, cur], axis=2)

    kb, vb = key_blocks(k), key_blocks(v)
    scale = 1.0 / math.sqrt(hd)
    s = jnp.einsum('nbqhgd,nbkhd->nbhgqk', qb, kb).astype(jnp.float32) * scale
    qi = jnp.arange(blk)[:, None]
    kj = jnp.arange(2 * blk)[None, :]
    dist = qi + blk - kj
    key_pos = (jnp.arange(nb) * blk)[:, None, None] - blk + kj[None]
    valid = (dist >= 0)[None] & (dist <= max_dist)[None] & (key_pos >= 0)
    s = jnp.where(valid[None, :, None, None], s, -jnp.inf)
    m = jnp.max(s, axis=-1, keepdims=True)
    if sink is not None:
        sk = sink.astype(jnp.float32)[None, None, :, :, None, None]
        m = jnp.maximum(m, sk)
    p = jnp.exp(s - m)
    denom = jnp.sum(p, axis=-1, keepdims=True)
    if sink is not None:
        denom = denom + jnp.exp(sk - m)
    lse = (m + jnp.log(denom))[..., 0]
    out = jnp.einsum('nbhgqk,nbkhd->nbqhgd', p / denom, vb.astype(jnp.float32))
    out = out.reshape(n, lp, hkv, grp, hd)[:, :seq_len].astype(q.dtype)
    lse = lse.transpose(0, 1, 4, 2, 3).reshape(n, lp, hkv, grp)[:, :seq_len]
    return out, lse


def forgetting_attention(q, k, v, log_f):
    b, seq, h, hd = q.shape
    nb = seq // Q_BLOCK
    c = jnp.cumsum(log_f, axis=1)
    c_keys = c.transpose(0, 2, 1)[:, :, None, :]
    qb = q.reshape(b, nb, Q_BLOCK, h, hd).transpose(1, 0, 2, 3, 4)
    cqb = c.reshape(b, nb, Q_BLOCK, h).transpose(1, 0, 3, 2)
    vf = v.astype(jnp.float32)
    scale = 1.0 / math.sqrt(hd)
    key_idx = jnp.arange(seq)

    def one_block(args):
        qn, cqn, blk_idx = args
        s = jnp.einsum('bqhd,bkhd->bhqk', qn, k).astype(jnp.float32) * scale
        s = s + cqn[..., None] - c_keys
        qpos = blk_idx * Q_BLOCK + jnp.arange(Q_BLOCK)
        s = jnp.where(key_idx[None, :] <= qpos[:, None], s, -jnp.inf)
        p = jax.nn.softmax(s, axis=-1)
        return jnp.einsum('bhqk,bkhd->bqhd', p, vf)

    out = lax.map(one_block, (qb, cqb, jnp.arange(nb)))
    return out.transpose(1, 0, 2, 3, 4).reshape(b, seq, h, hd).astype(q.dtype)


def dilated_mixture_attention(q, k, v):
    b, seq, h, hd = q.shape
    outs, lses = [], []
    for window, dil in DILATED_PATTERNS:
        sub_len = seq // dil

        def to_sub(t):
            return t.reshape(b, sub_len, dil, h, hd).transpose(0, 2, 1, 3, 4).reshape(b * dil, sub_len, h, hd)

        o, lse = banded_attention(to_sub(q)[:, :, :, None, :], to_sub(k), to_sub(v), window // dil)
        o = o.reshape(b, dil, sub_len, h, hd).transpose(0, 2, 1, 3, 4).reshape(b, seq, h, hd)
        lse = lse.reshape(b, dil, sub_len, h).transpose(0, 2, 1, 3).reshape(b, seq, h)
        outs.append(o.astype(jnp.float32))
        lses.append(lse)
    w = jax.nn.softmax(jnp.stack(lses, axis=0), axis=0)
    out = jnp.sum(w[..., None] * jnp.stack(outs, axis=0), axis=0)
    return out.astype(q.dtype)


def setup_inputs(seed: int = 0) -> dict:
    key = jax.random.key(seed)
    ks = jax.random.split(key, 10)
    f32 = jnp.float32
    x = jax.random.normal(ks[0], (BATCH, SEQ, D_MODEL), f32)
    norm_g = 1.0 + 0.05 * jax.random.normal(ks[1], (DEPTH, D_MODEL), f32)
    w_in = jax.random.normal(ks[2], (DEPTH, D_MODEL, IN_COLS), f32) * D_MODEL ** -0.5
    b_forget = 2.5 + 0.5 * jax.random.normal(ks[3], (DEPTH, A_HEADS), f32)
    sinks = 0.5 * jax.random.normal(ks[4], (DEPTH, C_Q_HEADS), f32)
    w_br_a = jax.random.normal(ks[5], (DEPTH, A_W, D_MODEL), f32) * A_W ** -0.5
    w_br_b = jax.random.normal(ks[6], (DEPTH, B_W, D_MODEL), f32) * B_W ** -0.5
    w_br_c = jax.random.normal(ks[7], (DEPTH, C_W, D_MODEL), f32) * C_W ** -0.5
    w_out = jax.random.normal(ks[8], (DEPTH, D_MODEL, D_MODEL), f32) * D_MODEL ** -0.5
    final_norm_g = 1.0 + 0.05 * jax.random.normal(ks[9], (D_MODEL,), f32)
    return {"x": x, "norm_g": norm_g, "w_in": w_in, "b_forget": b_forget, "sinks": sinks,
            "w_br_a": w_br_a, "w_br_b": w_br_b, "w_br_c": w_br_c, "w_out": w_out,
            "final_norm_g": final_norm_g}


def reference(x, norm_g, w_in, b_forget, sinks, w_br_a, w_br_b, w_br_c, w_out, final_norm_g):
    b, seq, _ = x.shape
    cos, sin = rope_tables(seq)
    offsets = np.cumsum(np.array(SPLIT_SIZES))[:-1].tolist()
    for layer in range(DEPTH):
        h = rmsnorm(x, norm_g[layer])
        u = jnp.einsum('bsd,dc->bsc', h, w_in[layer])
        (qa, ka, va, fa, za,
         qb, kb, vb, zb,
         qc, kc, vc, zc,
         ga, gb, gc) = jnp.split(u, offsets, axis=-1)

        log_f = jax.nn.log_sigmoid(fa.astype(jnp.float32) + b_forget[layer].astype(jnp.float32))
        ya = forgetting_attention(qa.reshape(b, seq, A_HEADS, HEAD_DIM),
                                  ka.reshape(b, seq, A_HEADS, HEAD_DIM),
                                  va.reshape(b, seq, A_HEADS, HEAD_DIM), log_f)
        ya = ya.reshape(b, seq, A_W) * jax.nn.silu(za)

        qb_h = apply_rope(qb.reshape(b, seq, B_HEADS, HEAD_DIM), cos, sin)
        kb_h = apply_rope(kb.reshape(b, seq, B_HEADS, HEAD_DIM), cos, sin)
        yb = dilated_mixture_attention(qb_h, kb_h, vb.reshape(b, seq, B_HEADS, HEAD_DIM))
        yb = yb.reshape(b, seq, B_W) * jax.nn.silu(zb)

        qc_h = apply_rope(qc.reshape(b, seq, C_Q_HEADS, HEAD_DIM), cos, sin)
        qc_h = qc_h.reshape(b, seq, C_KV_HEADS, C_GROUP, HEAD_DIM)
        kc_h = apply_rope(kc.reshape(b, seq, C_KV_HEADS, HEAD_DIM), cos, sin)
        vc_h = vc.reshape(b, seq, C_KV_HEADS, HEAD_DIM)
        yc, _ = banded_attention(qc_h, kc_h, vc_h, SWA_WINDOW - 1,
                                 sinks[layer].reshape(C_KV_HEADS, C_GROUP))
        yc = yc.reshape(b, seq, C_W) * jax.nn.silu(zc)

        merged = (jax.nn.sigmoid(ga) * jnp.einsum('bsc,cd->bsd', ya, w_br_a[layer])
                  + jax.nn.sigmoid(gb) * jnp.einsum('bsc,cd->bsd', yb, w_br_b[layer])
                  + jax.nn.sigmoid(gc) * jnp.einsum('bsc,cd->bsd', yc, w_br_c[layer]))
        x = x + jnp.einsum('bsd,de->bse', merged, w_out[layer])
    return rmsnorm(x, final_norm_g)
```

```cpp
#include <hip/hip_runtime.h>
#include <hip/hip_cooperative_groups.h>
#include <cstdio>
#include <cstdint>
#include <cmath>
namespace cg = cooperative_groups;

#define LAS __attribute__((address_space(3)))
#define GAS __attribute__((address_space(1)))
typedef unsigned short bf16_t;
typedef short bf16x8 __attribute__((ext_vector_type(8)));
typedef short s16x4 __attribute__((ext_vector_type(4)));
typedef float f32x4 __attribute__((ext_vector_type(4)));
typedef float f32x16 __attribute__((ext_vector_type(16)));
typedef unsigned u32x4 __attribute__((ext_vector_type(4)));
typedef unsigned u32x2 __attribute__((ext_vector_type(2)));

constexpr int SEQ = 2048, NBATCH = 16, M = NBATCH * SEQ, D = 1024;
constexpr int NIN = 6660;
constexpr int NP = 6656;
constexpr int NQ = 3584;
constexpr int NGC = 3072;
constexpr float LOG2E = 1.4426950408889634f;
constexpr float C2 = 0.125f * LOG2E;
constexpr float RMS_EPS = 1e-6f;

constexpr size_t MiB = 1u << 20;
constexpr size_t WS_COS = 1 * MiB;
constexpr size_t WS_SIN = WS_COS + 256 * 1024;
constexpr size_t WS_LOGF = WS_SIN + 256 * 1024;
constexpr size_t WS_CB = WS_LOGF + 512 * 1024;
constexpr size_t WS_LSE = WS_CB + 512 * 1024;
constexpr size_t WS_SLOTS = 512 * 1024;
constexpr size_t WS_WIN = 4 * MiB;
constexpr size_t WS_WBR = 17 * MiB;
constexpr size_t WS_WOUT = 19 * MiB;
constexpr size_t WS_H = 22 * MiB;
constexpr size_t WS_QKVZ = 86 * MiB;
constexpr size_t WS_G = 310 * MiB;
constexpr size_t WS_END = 502 * MiB;

constexpr int LDS_BYTES = 147456;
constexpr int NTHREADS = 512;
#ifndef PROBE_REP_GEMM1
#define PROBE_REP_GEMM1 1
#endif
#ifndef PROBE_REP_MERGE
#define PROBE_REP_MERGE 1
#endif
#ifndef PROBE_REP_PREP
#define PROBE_REP_PREP 1
#endif
#ifndef PROBE_REP_ATT0
#define PROBE_REP_ATT0 1
#endif

__device__ __forceinline__ unsigned f2bf(float f) { unsigned u = __builtin_bit_cast(unsigned, f); return (u + 0x7fffu + ((u >> 16) & 1u)) >> 16; }
typedef float f32x2_t __attribute__((ext_vector_type(2))); typedef __bf16 bf16x2_t __attribute__((ext_vector_type(2)));
__device__ __forceinline__ unsigned pk2(float lo, float hi) { f32x2_t v = {lo, hi}; bf16x2_t b = __builtin_convertvector(v, bf16x2_t); return __builtin_bit_cast(unsigned, b); }
__device__ __forceinline__ float bflo(unsigned w) { return __builtin_bit_cast(float, w << 16); }
__device__ __forceinline__ float bfhi(unsigned w) { return __builtin_bit_cast(float, w & 0xffff0000u); }
__device__ __forceinline__ float ex2(float x) { return __builtin_amdgcn_exp2f(x); }
__device__ __forceinline__ float rcpf_(float x) { return __builtin_amdgcn_rcpf(x); }
__device__ __forceinline__ float bperm(float v, int src_lane) { return __builtin_bit_cast(float, __builtin_amdgcn_ds_bpermute(src_lane << 2, __builtin_bit_cast(int, v))); }

namespace pg8 {
constexpr int BM = 256, BK = 64, HALF = 128, HTB = HALF * BK * 2, STAGE_BYTES = 8 * HTB, NXCD = 8, WGM = 8, LD = 1024;
__device__ __forceinline__ int lds_byte(int r, int c) { const int st = (r >> 4) * 2 + (c >> 5), rr = r & 15, cc = c & 31, ob = rr * 64 + cc * 2; return st * 1024 + (ob ^ (((ob >> 9) & 1) << 5)); }
__device__ __forceinline__ void stage_rc(int b, int& R, int& C) { const int st = b / 1024, sb = b % 1024, swz = sb ^ (((sb >> 9) & 1) << 5); R = (st >> 1) * 16 + swz / 64; C = (st & 1) * 32 + (swz % 64) / 2; }
__device__ __forceinline__ int perm32(int rho) { const int n = rho >> 4, i = rho & 15; return 8 * (i >> 2) + 4 * n + (i & 3); }

struct Unit { int pm, pn, k0, nt, mode; };

struct StaticOrder {
    int nM, nN, nwg, G, c;
    __device__ void init(int M_, int N_, int G_, int c_) { nM = M_ / BM; nN = N_ / BM; nwg = nM * nN; G = G_; c = c_; }
    __device__ bool next(int i, Unit& u) const {
        const long L = (long)i * G + c; if (L >= nwg) return false;
        int wgid = (int)L; { const int q = nwg / NXCD, r = nwg % NXCD, xcd = wgid % NXCD, off = wgid / NXCD; wgid = (xcd < r ? xcd * (q + 1) : r * (q + 1) + (xcd - r) * q) + off; }
        const int nig = WGM * nN, gid = wgid / nig, fm = gid * WGM, gsz = (nM - fm) < WGM ? (nM - fm) : WGM;
        u.pm = fm + ((wgid % nig) % gsz); u.pn = (wgid % nig) / gsz; return true;
    }
};
struct Sched {
    StaticOrder so; int kind;
    __device__ bool next(int i, Unit& u) const {
        if (kind == 1) { const int t = i / 3, br = i - 3 * t; if (!so.next(t, u)) return false; u.k0 = br == 0 ? 0 : (br == 1 ? 256 : 640); u.nt = br == 0 ? 4 : 6; u.mode = 1 + br; return true; }
        if (!so.next(i, u)) return false; u.k0 = 0; u.nt = 16; u.mode = kind == 0 ? 0 : 4; return true;
    }
};

struct Epi {
    bf16_t* QKVZ; bf16_t* Gt; bf16_t* MERGED; const float* xin; float* xout; const float* cosT; const float* sinT;
    const float* gfin; bf16_t* Hout; unsigned* slots; unsigned* cnt; LAS unsigned char* xl;
    __device__ __forceinline__ static int blockop(int blk) {
        if (blk >= 28) return 3;
        if (blk < 8) return blk < 2 ? 1 : (blk < 6 ? 0 : 2);
        if (blk < 20) { const int t = blk - 8; return t < 3 ? 5 : (t < 6 ? 4 : (t < 9 ? 0 : 2)); }
        const int t = blk - 20; return t < 3 ? 5 : (t == 3 ? 4 : (t == 4 ? 0 : 2));
    }
    template <int KIND> __device__ __forceinline__ void run(f32x4 (&acc)[2][2][4][2], const Unit& u, int wr, int wc, int fr, int fq) const {
        const int rl = wr * 64 + fr, cl = wc * 32 + 8 * fq;
        if constexpr (KIND == 1) {
            const int br = u.mode - 1;
            const char* gbase = (const char*)(Gt + br * 1024 + u.pn * BM) + (size_t)u.pm * BM * NGC * 2;
            unsigned goff = (unsigned)(rl * NGC + cl) * 2u;
            const int gnext = br < 2 ? 2048 : 0;
            const bool rt = br < 2;
#pragma unroll
            for (int bj = 0; bj < 2; ++bj)
#pragma unroll
                for (int ai = 0; ai < 2; ++ai) {
                    u32x4 ga[4], gb[4];
#pragma unroll
                    for (int m = 0; m < 4; ++m) { const char* gp = gbase + (size_t)(ai * HALF + m * 16) * NGC * 2 + bj * 256 + goff; ga[m] = *(const u32x4*)gp; gb[m] = *(const u32x4*)(gp + gnext); }
#pragma unroll
                    for (int m = 0; m < 4; ++m) {
                        f32x4 f0, f1;
                        f0[0] = bflo(ga[m].x) * (rt ? rcpf_(bflo(gb[m].x)) : 1.f); f0[1] = bfhi(ga[m].x) * (rt ? rcpf_(bfhi(gb[m].x)) : 1.f); f0[2] = bflo(ga[m].y) * (rt ? rcpf_(bflo(gb[m].y)) : 1.f); f0[3] = bfhi(ga[m].y) * (rt ? rcpf_(bfhi(gb[m].y)) : 1.f);
                        f1[0] = bflo(ga[m].z) * (rt ? rcpf_(bflo(gb[m].z)) : 1.f); f1[1] = bfhi(ga[m].z) * (rt ? rcpf_(bfhi(gb[m].z)) : 1.f); f1[2] = bflo(ga[m].w) * (rt ? rcpf_(bflo(gb[m].w)) : 1.f); f1[3] = bfhi(ga[m].w) * (rt ? rcpf_(bfhi(gb[m].w)) : 1.f);
#define PKMUL_INPLACE(A, F) do { f32x2_t lo_ = {(A)[0], (A)[1]}, hi_ = {(A)[2], (A)[3]}; const f32x2_t fl_ = {(F)[0], (F)[1]}, fh_ = {(F)[2], (F)[3]}; \
        asm volatile("v_pk_mul_f32 %0, %0, %1" : "+v"(lo_) : "v"(fl_)); asm volatile("v_pk_mul_f32 %0, %0, %1" : "+v"(hi_) : "v"(fh_)); (A) = (f32x4){lo_[0], lo_[1], hi_[0], hi_[1]}; } while (0)
                        PKMUL_INPLACE(acc[ai][bj][m][0], f0); PKMUL_INPLACE(acc[ai][bj][m][1], f1);
                    }
                    asm volatile("" : "+v"(goff));
                }
            if (br == 2) {
                char* mbase = (char*)(MERGED + u.pn * BM) + (size_t)u.pm * BM * 1024 * 2;
                const unsigned moff = (unsigned)(rl * 1024 + cl) * 2u;
#pragma unroll
                for (int bj = 0; bj < 2; ++bj)
#pragma unroll
                    for (int ai = 0; ai < 2; ++ai)
#pragma unroll
                        for (int m = 0; m < 4; ++m) {
                            const f32x4 v0 = acc[ai][bj][m][0], v1 = acc[ai][bj][m][1];
                            u32x4 w; w.x = pk2(v0[0], v0[1]); w.y = pk2(v0[2], v0[3]); w.z = pk2(v1[0], v1[1]); w.w = pk2(v1[2], v1[3]);
                            *(u32x4*)(mbase + (size_t)(ai * HALF + m * 16) * 2048 + bj * 256 + moff) = w;
                        }
            }
            const float keep = br == 2 ? 0.f : 1.f;
#pragma unroll
            for (int bj = 0; bj < 2; ++bj)
#pragma unroll
                for (int ai = 0; ai < 2; ++ai)
#pragma unroll
                    for (int m = 0; m < 4; ++m) { const f32x4 k4 = (f32x4){keep, keep, keep, keep}; PKMUL_INPLACE(acc[ai][bj][m][0], k4); PKMUL_INPLACE(acc[ai][bj][m][1], k4); }
            return;
        }
        if constexpr (KIND == 0) {
            const unsigned toff = (unsigned)(rl * 32 + 16 * (wc & 1) + 4 * fq) * 4u;
            const char* cbase = (const char*)cosT + (size_t)((u.pm & 7) * 256) * 128; const char* sbase = (const char*)sinT + (size_t)((u.pm & 7) * 256) * 128;
#pragma unroll
            for (int bj = 0; bj < 2; ++bj) {
                const int blk = 2 * u.pn + bj, op = blockop(blk);
                const int ld = blk < 28 ? NQ : NGC;
                char* base = (char*)(blk < 28 ? QKVZ + blk * 128 : Gt + (blk - 28) * 128) + (size_t)u.pm * BM * ld * 2;
                const unsigned voff = (unsigned)(rl * ld + cl) * 2u;
                if (op >= 4) {
                    const float sc = op == 5 ? C2 : 1.f;
                    f32x4 c4[8], s4[8];
#pragma unroll
                    for (int q = 0; q < 8; ++q) { const int dr = (q >> 2) * HALF + (q & 3) * 16; c4[q] = *(const f32x4*)(cbase + dr * 128 + toff); s4[q] = *(const f32x4*)(sbase + dr * 128 + toff); }
                    asm volatile("" ::: "memory");
#pragma unroll
                    for (int q = 0; q < 8; ++q) {
                        const int ai = q >> 2, m = q & 3, dr = ai * HALF + m * 16;
                        const f32x4 v0 = acc[ai][bj][m][0], v1 = acc[ai][bj][m][1];
                        const f32x4 cc = c4[q] * sc, ss = s4[q] * sc;
                        u32x4 w;
                        w.x = pk2(v0[0] * cc[0] - v0[1] * ss[0], v0[1] * cc[0] + v0[0] * ss[0]);
                        w.y = pk2(v0[2] * cc[1] - v0[3] * ss[1], v0[3] * cc[1] + v0[2] * ss[1]);
                        w.z = pk2(v1[0] * cc[2] - v1[1] * ss[2], v1[1] * cc[2] + v1[0] * ss[2]);
                        w.w = pk2(v1[2] * cc[3] - v1[3] * ss[3], v1[3] * cc[3] + v1[2] * ss[3]);
                        __builtin_nontemporal_store(w, (u32x4*)(base + (size_t)dr * ld * 2 + voff));
                    }
                    asm volatile("" ::: "memory");
                } else if (op >= 2) {
#pragma unroll
                    for (int ai = 0; ai < 2; ++ai)
#pragma unroll
                        for (int m = 0; m < 4; ++m) {
                            const int dr = ai * HALF + m * 16;
                            f32x4 v0 = acc[ai][bj][m][0], v1 = acc[ai][bj][m][1];
#pragma unroll
                            for (int e = 0; e < 4; ++e) {
                                const float s0 = rcpf_(1.f + ex2(-LOG2E * v0[e])), s1 = rcpf_(1.f + ex2(-LOG2E * v1[e]));
                                v0[e] = op == 2 ? v0[e] * s0 : s0; v1[e] = op == 2 ? v1[e] * s1 : s1;
                            }
                            u32x4 w; w.x = pk2(v0[0], v0[1]); w.y = pk2(v0[2], v0[3]); w.z = pk2(v1[0], v1[1]); w.w = pk2(v1[2], v1[3]);
                            __builtin_nontemporal_store(w, (u32x4*)(base + (size_t)dr * ld * 2 + voff));
                            asm volatile("" ::: "memory");
                        }
                } else {
                    const float sc = op == 1 ? C2 : 1.f;
#pragma unroll
                    for (int ai = 0; ai < 2; ++ai)
#pragma unroll
                        for (int m = 0; m < 4; ++m) {
                            const int dr = ai * HALF + m * 16;
                            const f32x4 v0 = acc[ai][bj][m][0] * sc, v1 = acc[ai][bj][m][1] * sc;
                            u32x4 w; w.x = pk2(v0[0], v0[1]); w.y = pk2(v0[2], v0[3]); w.z = pk2(v1[0], v1[1]); w.w = pk2(v1[2], v1[3]);
                            __builtin_nontemporal_store(w, (u32x4*)(base + (size_t)dr * ld * 2 + voff));
                            asm volatile("" ::: "memory");
                        }
                }
            }
        } else if constexpr (KIND == 3 || KIND == 4) {
            const int tid = (wr * 4 + wc) * 64 + fq * 16 + fr;
            const char* ib = (const char*)(xin + u.pn * BM) + (size_t)u.pm * BM * 4096; char* ob = (char*)(xout + u.pn * BM) + (size_t)u.pm * BM * 4096;
            const unsigned xoff = (unsigned)(rl * 1024 + cl) * 4u;
#define PKADD_INPLACE(A, X) do { f32x2_t lo_ = {(A)[0], (A)[1]}, hi_ = {(A)[2], (A)[3]}; const f32x2_t xl_ = {(X)[0], (X)[1]}, xh_ = {(X)[2], (X)[3]}; \
        asm volatile("v_pk_add_f32 %0, %0, %1" : "+v"(lo_) : "v"(xl_)); asm volatile("v_pk_add_f32 %0, %0, %1" : "+v"(hi_) : "v"(xh_)); (A) = (f32x4){lo_[0], lo_[1], hi_[0], hi_[1]}; } while (0)
            unsigned xo = xoff;
#pragma unroll
            for (int bj = 0; bj < 2; ++bj) {
                f32x4 x0[8], x1[8];
#pragma unroll
                for (int q = 0; q < 8; ++q) { const size_t uo = (size_t)((q >> 2) * HALF + (q & 3) * 16) * 4096 + bj * 512; x0[q] = __builtin_nontemporal_load((const f32x4*)(ib + uo + xo)); x1[q] = __builtin_nontemporal_load((const f32x4*)(ib + uo + xo + 16)); }
#pragma unroll
                for (int q = 0; q < 8; ++q) { PKADD_INPLACE(acc[q >> 2][bj][q & 3][0], x0[q]); PKADD_INPLACE(acc[q >> 2][bj][q & 3][1], x1[q]); }
                asm volatile("" : "+v"(xo));
            }
            LAS float* P = (LAS float*)xl;
            LAS float* Sr = (LAS float*)(xl + 4096);
#pragma unroll
            for (int ai = 0; ai < 2; ++ai)
#pragma unroll
                for (int m = 0; m < 4; ++m) {
                    float sq = 0.f;
#pragma unroll
                    for (int bj = 0; bj < 2; ++bj)
#pragma unroll
                        for (int n = 0; n < 2; ++n) { const f32x4 v = acc[ai][bj][m][n]; sq += (v[0] * v[0] + v[1] * v[1]) + (v[2] * v[2] + v[3] * v[3]); }
                    sq += bperm(sq, (fq * 16 + fr) ^ 16); sq += bperm(sq, (fq * 16 + fr) ^ 32);
                    if (fq == 0) P[(ai * HALF + rl + m * 16) * 4 + wc] = sq;
                }
            asm volatile("s_waitcnt lgkmcnt(0)" ::: "memory"); __builtin_amdgcn_s_barrier(); asm volatile("" ::: "memory");
            if (tid < 256) {
                const f32x4 p4 = *(LAS const f32x4*)(P + tid * 4);
                __hip_atomic_store(slots + ((size_t)(u.pm * BM + tid) * 4 + u.pn), __float_as_uint((p4[0] + p4[1]) + (p4[2] + p4[3])), __ATOMIC_RELAXED, __HIP_MEMORY_SCOPE_AGENT);
            }
            asm volatile("s_waitcnt vmcnt(0)" ::: "memory"); __builtin_amdgcn_s_barrier(); asm volatile("" ::: "memory");
            if (tid == 0) {
                __hip_atomic_fetch_add(cnt + 64 * u.pm, 1u, __ATOMIC_RELAXED, __HIP_MEMORY_SCOPE_AGENT);
                unsigned sp = 0;
                while (__hip_atomic_load(cnt + 64 * u.pm, __ATOMIC_RELAXED, __HIP_MEMORY_SCOPE_AGENT) < 4u) { __builtin_amdgcn_s_sleep(2); if (++sp > (1u << 22)) break; }
                __builtin_amdgcn_fence(__ATOMIC_ACQUIRE, "agent");
            }
            asm volatile("s_waitcnt vmcnt(0) lgkmcnt(0)" ::: "memory"); __builtin_amdgcn_s_barrier(); asm volatile("" ::: "memory");
            if (tid < 256) {
                const unsigned* sl = slots + (size_t)(u.pm * BM + tid) * 4; float ss = 0.f;
#pragma unroll
                for (int t4 = 0; t4 < 4; ++t4) ss += __uint_as_float(__hip_atomic_load(sl + t4, __ATOMIC_RELAXED, __HIP_MEMORY_SCOPE_AGENT));
                Sr[tid] = 1.0f / sqrtf(ss * (1.f / 1024.f) + RMS_EPS);
            }
            asm volatile("s_waitcnt lgkmcnt(0)" ::: "memory"); __builtin_amdgcn_s_barrier(); asm volatile("" ::: "memory");
#pragma unroll
            for (int bj = 0; bj < 2; ++bj) {
                const f32x4 g0 = *(const f32x4*)(gfin + u.pn * BM + bj * HALF + cl), g1 = *(const f32x4*)(gfin + u.pn * BM + bj * HALF + cl + 4);
#pragma unroll
                for (int q = 0; q < 8; ++q) { const size_t uo = (size_t)((q >> 2) * HALF + (q & 3) * 16) * 4096 + bj * 512; const float rs = Sr[(q >> 2) * HALF + rl + (q & 3) * 16];
                    const f32x4 h0 = acc[q >> 2][bj][q & 3][0] * rs * g0, h1 = acc[q >> 2][bj][q & 3][1] * rs * g1;
                    if constexpr (KIND == 3) { __builtin_nontemporal_store(h0, (f32x4*)(ob + uo + xoff)); __builtin_nontemporal_store(h1, (f32x4*)(ob + uo + xoff + 16)); }
                    else { __builtin_nontemporal_store(acc[q >> 2][bj][q & 3][0], (f32x4*)(ob + uo + xoff)); __builtin_nontemporal_store(acc[q >> 2][bj][q & 3][1], (f32x4*)(ob + uo + xoff + 16));
                        u32x4 w; w.x = pk2(h0[0], h0[1]); w.y = pk2(h0[2], h0[3]); w.z = pk2(h1[0], h1[1]); w.w = pk2(h1[2], h1[3]);
                        *(u32x4*)((char*)(Hout + u.pn * BM) + (size_t)u.pm * BM * 2048 + (uo >> 1) + (xoff >> 1)) = w; } }
                asm volatile("" ::: "memory");
            }
            asm volatile("s_waitcnt lgkmcnt(0)" ::: "memory"); __builtin_amdgcn_s_barrier(); asm volatile("" ::: "memory");
        } else if constexpr (KIND == 2) {
            const char* ib = (const char*)(xin + u.pn * BM) + (size_t)u.pm * BM * 4096; char* ob = (char*)(xout + u.pn * BM) + (size_t)u.pm * BM * 4096;
            const unsigned xoff = (unsigned)(rl * 1024 + cl) * 4u;
#pragma unroll
            for (int bj = 0; bj < 2; ++bj) {
                f32x4 x0[8], x1[8];
#pragma unroll
                for (int q = 0; q < 8; ++q) { const size_t uo = (size_t)((q >> 2) * HALF + (q & 3) * 16) * 4096 + bj * 512; x0[q] = *(const f32x4*)(ib + uo + xoff); x1[q] = *(const f32x4*)(ib + uo + xoff + 16); }
                asm volatile("" ::: "memory");
#pragma unroll
                for (int q = 0; q < 8; ++q) { const size_t uo = (size_t)((q >> 2) * HALF + (q & 3) * 16) * 4096 + bj * 512;
                    *(f32x4*)(ob + uo + xoff) = x0[q] + acc[q >> 2][bj][q & 3][0]; *(f32x4*)(ob + uo + xoff + 16) = x1[q] + acc[q >> 2][bj][q & 3][1]; }
                asm volatile("" ::: "memory");
            }
        }
#pragma unroll
        for (int bj = 0; bj < 2; ++bj)
#pragma unroll
            for (int ai = 0; ai < 2; ++ai)
#pragma unroll
                for (int m = 0; m < 4; ++m) { acc[ai][bj][m][0] = (f32x4){0.f, 0.f, 0.f, 0.f}; acc[ai][bj][m][1] = (f32x4){0.f, 0.f, 0.f, 0.f}; }
    }
};

template <int KIND> __device__ __forceinline__ void gemm_phase(LAS unsigned char* lds, const bf16_t* A, const bf16_t* Bt, const Sched& S, const Epi& E) {
    int tid_ = threadIdx.x; asm volatile("" : "+v"(tid_));
    const int tid = tid_, wid = __builtin_amdgcn_readfirstlane(tid >> 6), lane = tid & 63, wr = wid >> 2, wc = wid & 3, fr = lane & 15, fq = lane >> 4;
    unsigned voffA[2], voffB[2];
#pragma unroll
    for (int i = 0; i < 2; ++i) { int R, C; stage_rc(tid * 16 + i * 8192, R, C); const int Rb = (R & ~31) + perm32(R & 31);
        voffA[i] = (unsigned)(R * LD + C) * 2u; voffB[i] = (unsigned)(Rb * LD + C) * 2u; }
    const size_t kstep = (size_t)(BK * 2);
    const size_t hstep = (size_t)HALF * LD * 2;
    const size_t tstep = 2 * hstep;
    const unsigned ldsw = (unsigned)wid * 1024u;
    const int aoff = lds_byte(wr * 64 + fr, fq * 8), boff = lds_byte(wc * 32 + fr, fq * 8);
#define PG8_SA(b, h) (((b) * 2 + (h)) * HTB)
#define PG8_SB(b, h) ((4 + (b) * 2 + (h)) * HTB)
#define PG8_STAGE(bufoff, gbase, voff) do { _Pragma("unroll") for (int _i = 0; _i < 2; ++_i) \
        __builtin_amdgcn_global_load_lds((const unsigned*)((const char*)(gbase) + (voff)[_i]), (LAS unsigned*)(lds + (bufoff) + ldsw + _i * 8192), 16, 0, 0); } while (0)
#define PG8_LDA(dst, b, h) do { _Pragma("unroll") for (int m = 0; m < 4; ++m) _Pragma("unroll") for (int k = 0; k < 2; ++k) dst[m][k] = *(const LAS bf16x8*)(lds + PG8_SA(b, h) + aoff + m * 2048 + k * 1024); } while (0)
#define PG8_LDB(dst, b, h) do { _Pragma("unroll") for (int n = 0; n < 2; ++n) _Pragma("unroll") for (int k = 0; k < 2; ++k) dst[n][k] = *(const LAS bf16x8*)(lds + PG8_SB(b, h) + boff + n * 2048 + k * 1024); } while (0)
#define PG8_MMA(ai, bj, At, Bt_) do { __builtin_amdgcn_s_setprio(1); _Pragma("unroll") for (int m = 0; m < 4; ++m) _Pragma("unroll") for (int n = 0; n < 2; ++n) _Pragma("unroll") for (int k = 0; k < 2; ++k) \
        acc[ai][bj][m][n] = __builtin_amdgcn_mfma_f32_16x16x32_bf16(Bt_[n][k], At[m][k], acc[ai][bj][m][n], 0, 0, 0); __builtin_amdgcn_s_setprio(0); } while (0)
#define PG8_WAIT_V(n) asm volatile("s_waitcnt vmcnt(" #n ")" ::: "memory")
#define PG8_WAIT_L(n) asm volatile("s_waitcnt lgkmcnt(" #n ")" ::: "memory")
#define PG8_BAR __builtin_amdgcn_s_barrier()
#define PG8_SCHED __builtin_amdgcn_sched_barrier(0)
    Unit cur, nxt; int ui = 0;
    if (!S.next(0, cur)) return;
    f32x4 acc[2][2][4][2];
#pragma unroll
    for (int a = 0; a < 2; ++a)
#pragma unroll
        for (int b = 0; b < 2; ++b)
#pragma unroll
            for (int m = 0; m < 4; ++m)
#pragma unroll
                for (int n = 0; n < 2; ++n) acc[a][b][m][n] = (f32x4){0.f, 0.f, 0.f, 0.f};
    bf16x8 At[4][2], B0[2][2], B1[2][2];
    const char* cA = (const char*)A + (size_t)cur.pm * tstep + (size_t)cur.k0 * 2; const char* cB = (const char*)Bt + (size_t)cur.pn * tstep + (size_t)cur.k0 * 2;
    PG8_STAGE(PG8_SB(0, 0), cB, voffB); PG8_STAGE(PG8_SB(0, 1), cB + hstep, voffB); PG8_STAGE(PG8_SA(0, 0), cA, voffA); PG8_STAGE(PG8_SA(0, 1), cA + hstep, voffA);
    if (wr == 1) PG8_BAR;
    PG8_WAIT_V(2); PG8_BAR;
    PG8_STAGE(PG8_SB(1, 0), cB + kstep, voffB); PG8_STAGE(PG8_SA(1, 0), cA + kstep, voffA); PG8_STAGE(PG8_SB(1, 1), cB + hstep + kstep, voffB);
    PG8_WAIT_V(6); PG8_BAR;
    for (;;) {
        const bool has_next = S.next(ui + 1, nxt);
        const char* nA = has_next ? (const char*)A + (size_t)nxt.pm * tstep + (size_t)nxt.k0 * 2 : cA; const char* nB = has_next ? (const char*)Bt + (size_t)nxt.pn * tstep + (size_t)nxt.k0 * 2 : cB;
        const int nt = cur.nt;
        for (int t = 0; t < nt; t += 2) {
            const bool last = (t == nt - 2);
            const char* a1 = cA + (size_t)(t + 1) * kstep;
            const char* a2 = last ? nA : cA + (size_t)(t + 2) * kstep; const char* b2 = last ? nB : cB + (size_t)(t + 2) * kstep;
            const char* a3 = a2 + kstep; const char* b3 = b2 + kstep;
            PG8_LDB(B0, 0, 0); PG8_LDB(B1, 0, 1); PG8_SCHED; PG8_LDA(At, 0, 0); PG8_STAGE(PG8_SA(1, 1), a1 + hstep, voffA);
            PG8_WAIT_V(8); PG8_WAIT_L(0); PG8_BAR; PG8_MMA(0, 0, At, B0); PG8_MMA(0, 1, At, B1); PG8_BAR; PG8_SCHED;
            PG8_LDA(At, 0, 1); PG8_STAGE(PG8_SB(0, 0), b2, voffB); PG8_STAGE(PG8_SB(0, 1), b2 + hstep, voffB); PG8_STAGE(PG8_SA(0, 0), a2, voffA);
            PG8_WAIT_V(8); PG8_WAIT_L(0); PG8_BAR; PG8_MMA(1, 0, At, B0); PG8_MMA(1, 1, At, B1); PG8_BAR; PG8_SCHED;
            PG8_LDB(B0, 1, 0); PG8_LDB(B1, 1, 1); PG8_SCHED; PG8_LDA(At, 1, 0); PG8_STAGE(PG8_SA(0, 1), a2 + hstep, voffA);
            PG8_WAIT_V(8); PG8_WAIT_L(0); PG8_BAR; PG8_MMA(0, 0, At, B0); PG8_MMA(0, 1, At, B1); PG8_BAR; PG8_SCHED;
            PG8_LDA(At, 1, 1); PG8_STAGE(PG8_SB(1, 0), b3, voffB); PG8_STAGE(PG8_SB(1, 1), b3 + hstep, voffB); PG8_STAGE(PG8_SA(1, 0), a3, voffA);
            PG8_WAIT_V(8); PG8_WAIT_L(0); PG8_BAR; PG8_MMA(1, 0, At, B0); PG8_MMA(1, 1, At, B1); PG8_BAR; PG8_SCHED;
        }
        if (wr == 0) PG8_BAR;
        E.template run<KIND>(acc, cur, wr, wc, fr, fq);
        if (!has_next) break;
        cur = nxt; cA = nA; cB = nB; ++ui;
        if (wr == 1) PG8_BAR;
    }
    PG8_WAIT_V(0);
    PG8_BAR;
#undef PG8_SA
#undef PG8_SB
#undef PG8_STAGE
#undef PG8_LDA
#undef PG8_LDB
#undef PG8_MMA
#undef PG8_WAIT_V
#undef PG8_WAIT_L
#undef PG8_BAR
#undef PG8_SCHED
}
}

struct Args {
    const float* x; const float* norm_g; const float* w_in; const float* b_forget; const float* sinks;
    const float* w_br_a; const float* w_br_b; const float* w_br_c; const float* w_out; const float* final_g;
    float* out; unsigned char* ws;
    float inv_freq[32];
};

__device__ __forceinline__ float wave_sum(float v, int lane) {
#pragma unroll
    for (int o = 1; o < 64; o <<= 1) v += bperm(v, lane ^ o);
    return v;
}
__device__ __forceinline__ int orig_col(int np) {
    if (np < 768) return np;
    const bool rope = (np >= 1024 && np < 1792) || (np >= 2560 && np < 3072);
    if (!rope) return np + 4;
    const int p = np & 63, base = np - p;
    return base + (p >> 1) + 32 * (p & 1) + 4;
}
__device__ __forceinline__ void transpose_item(const float* W, int ldw, bool permute, bf16_t* WT, int ldt, int kdst, LAS float* scr, int k0, int n0, int lane) {
    const int nn = n0 + (lane & 31), sc = permute ? orig_col(nn) : nn;
#pragma unroll 8
    for (int i = 0; i < 32; ++i) { const int kk = 2 * i + (lane >> 5); scr[kk * 33 + (lane & 31)] = __builtin_nontemporal_load(W + (size_t)(k0 + kk) * ldw + sc); }
    asm volatile("s_waitcnt lgkmcnt(0)" ::: "memory");
    const int c = lane & 7;
#pragma unroll
    for (int j = 0; j < 4; ++j) { const int n = (lane >> 3) + 8 * j; const LAS float* s = scr + (8 * c) * 33 + n;
        u32x4 o; o.x = pk2(s[0 * 33], s[1 * 33]); o.y = pk2(s[2 * 33], s[3 * 33]); o.z = pk2(s[4 * 33], s[5 * 33]); o.w = pk2(s[6 * 33], s[7 * 33]);
        *(u32x4*)(WT + (size_t)(n0 + n) * ldt + kdst + k0 + 8 * c) = o; }
    asm volatile("s_waitcnt lgkmcnt(0)" ::: "memory");
}

__device__ __forceinline__ void prep_phase(const Args& a, int layer, LAS unsigned char* lds, int vcu, int G) {
    int tid_ = threadIdx.x; asm volatile("" : "+v"(tid_));
    const int tid = tid_, lane = tid & 63, wave = __builtin_amdgcn_readfirstlane(tid >> 6);
    LAS float* scr = (LAS float*)(lds + wave * 16384);
    const int gw = vcu * 8 + wave, NGW = G * 8;
    unsigned char* ws = a.ws;
    const float* w_in = a.w_in + (size_t)layer * D * NIN;
    constexpr int I_IN = 16 * (NP / 32), I_A = 4 * 32, I_B = 6 * 32, I_C = 6 * 32, I_O = 16 * 32;
    constexpr int NITEMS = I_IN + I_A + I_B + I_C + I_O;
    for (int it = gw; it < NITEMS; it += NGW) {
        int r = it;
        if (r < I_IN) { const int nb = r % (NP / 32), kb = r / (NP / 32); transpose_item(w_in, NIN, true, (bf16_t*)(ws + WS_WIN), 1024, 0, scr, 64 * kb, 32 * nb, lane); continue; } r -= I_IN;
        if (r < I_A) { transpose_item(a.w_br_a + (size_t)layer * 256 * 1024, 1024, false, (bf16_t*)(ws + WS_WBR), 1024, 0, scr, 64 * (r / 32), 32 * (r % 32), lane); continue; } r -= I_A;
        if (r < I_B) { transpose_item(a.w_br_b + (size_t)layer * 384 * 1024, 1024, false, (bf16_t*)(ws + WS_WBR), 1024, 256, scr, 64 * (r / 32), 32 * (r % 32), lane); continue; } r -= I_B;
        if (r < I_C) { transpose_item(a.w_br_c + (size_t)layer * 384 * 1024, 1024, false, (bf16_t*)(ws + WS_WBR), 1024, 640, scr, 64 * (r / 32), 32 * (r % 32), lane); continue; } r -= I_C;
        transpose_item(a.w_out + (size_t)layer * 1024 * 1024, 1024, false, (bf16_t*)(ws + WS_WOUT), 1024, 0, scr, 64 * (r / 32), 32 * (r % 32), lane);
    }
    if (layer == 0) {
        float* cosT = (float*)(ws + WS_COS); float* sinT = (float*)(ws + WS_SIN);
        for (int e = vcu * NTHREADS + tid; e < SEQ * 32; e += G * NTHREADS) {
            const int pos = e >> 5, i = e & 31;
            const float angf = (float)pos * a.inv_freq[i];
            const double ang = (double)angf;
            const double n = __builtin_rint(ang * 0.15915494309189535);
            double r = ang - n * 6.283185307179586232; r -= n * 2.449293598294706414e-16;
            const double r2 = r * r;
            double cs = 1.0, sn = 1.0;
            double cc = 0.0, ss = 0.0;
#pragma unroll
            for (int k = 13; k >= 1; --k) { cc = (cc + 1.0) * (-r2 / (double)((2 * k - 1) * (2 * k))); ss = (ss + 1.0) * (-r2 / (double)((2 * k) * (2 * k + 1))); }
            cs = 1.0 + cc; sn = r * (1.0 + ss);
            cosT[e] = (float)cs; sinT[e] = (float)sn;
        }
    }
    const float* xin = layer == 0 ? a.x : a.out;
    const float* g = a.norm_g + layer * D;
    f32x4 gv[4], wf[16];
#pragma unroll
    for (int j = 0; j < 4; ++j) gv[j] = *(const f32x4*)(g + 256 * j + 4 * lane);
#pragma unroll
    for (int j = 0; j < 4; ++j)
#pragma unroll
        for (int e = 0; e < 4; ++e) wf[4 * j + e] = *(const f32x4*)(w_in + (size_t)(256 * j + 4 * lane + e) * NIN + 768);
    const f32x4 bfv = *(const f32x4*)(a.b_forget + 4 * layer);
    bf16_t* H = (bf16_t*)(ws + WS_H); float* logf = (float*)(ws + WS_LOGF);
    if (layer > 0) {
        for (int m = gw; m < M; m += NGW) {
            const u32x2* hr = (const u32x2*)(H + (size_t)m * D) + lane;
            f32x4 fa = (f32x4){0.f, 0.f, 0.f, 0.f};
#pragma unroll
            for (int j = 0; j < 4; ++j) { const u32x2 hw = hr[64 * j];
                fa += wf[4 * j + 0] * bflo(hw.x); fa += wf[4 * j + 1] * bfhi(hw.x); fa += wf[4 * j + 2] * bflo(hw.y); fa += wf[4 * j + 3] * bfhi(hw.y); }
            fa.x = wave_sum(fa.x, lane); fa.y = wave_sum(fa.y, lane); fa.z = wave_sum(fa.z, lane); fa.w = wave_sum(fa.w, lane);
            if (lane == 0) {
                f32x4 o;
#pragma unroll
                for (int e = 0; e < 4; ++e) { const float t = fa[e] + bfv[e]; o[e] = fminf(t, 0.f) - log1pf(expf(-fabsf(t))); }
                *(f32x4*)(logf + (size_t)m * 4) = o;
            }
        }
        return;
    }
    for (int m = gw; m < M; m += NGW) {
        const f32x4* xr = (const f32x4*)(xin + (size_t)m * D) + lane;
        f32x4 v[4]; float s2 = 0.f;
#pragma unroll
        for (int j = 0; j < 4; ++j) { v[j] = __builtin_nontemporal_load(xr + 64 * j); s2 += (v[j].x * v[j].x + v[j].y * v[j].y) + (v[j].z * v[j].z + v[j].w * v[j].w); }
        const float rs = 1.0f / sqrtf(wave_sum(s2, lane) * (1.f / D) + RMS_EPS);
        f32x4 fa = (f32x4){0.f, 0.f, 0.f, 0.f};
        unsigned long long* o8 = (unsigned long long*)(H + (size_t)m * D) + lane;
#pragma unroll
        for (int j = 0; j < 4; ++j) {
            const f32x4 h = v[j] * rs * gv[j];
            fa += wf[4 * j + 0] * h.x; fa += wf[4 * j + 1] * h.y; fa += wf[4 * j + 2] * h.z; fa += wf[4 * j + 3] * h.w;
            o8[64 * j] = (unsigned long long)pk2(h.x, h.y) | ((unsigned long long)pk2(h.z, h.w) << 32);
        }
        fa.x = wave_sum(fa.x, lane); fa.y = wave_sum(fa.y, lane); fa.z = wave_sum(fa.z, lane); fa.w = wave_sum(fa.w, lane);
        if (lane == 0) {
            f32x4 o;
#pragma unroll
            for (int e = 0; e < 4; ++e) { const float t = fa[e] + bfv[e]; o[e] = fminf(t, 0.f) - log1pf(expf(-fabsf(t))); }
            *(f32x4*)(logf + (size_t)m * 4) = o;
        }
    }
}

__device__ __forceinline__ void cumsum_phase(const Args& a, int blk) {
    if (blk >= 8) return;
    int tid_ = threadIdx.x; asm volatile("" : "+v"(tid_));
    const int tid = tid_, lane = tid & 63, w = tid >> 6, seq = blk * 8 + w, b = seq >> 2, h = seq & 3;
    const float* lf = (const float*)(a.ws + WS_LOGF) + ((size_t)b * SEQ + 32 * lane) * 4 + h;
    float* cb = (float*)(a.ws + WS_CB) + (size_t)(b * 4 + h) * SEQ + 32 * lane;
    float v[32]; float run = 0.f;
#pragma unroll
    for (int i = 0; i < 32; ++i) { run += lf[4 * i]; v[i] = run; }
    float x = run;
#pragma unroll
    for (int o = 1; o < 64; o <<= 1) { const float t = bperm(x, lane >= o ? lane - o : lane); if (lane >= o) x += t; }
    const float excl = x - run;
#pragma unroll
    for (int i = 0; i < 32; i += 4) { f32x4 o4; o4.x = -LOG2E * (excl + v[i]); o4.y = -LOG2E * (excl + v[i + 1]); o4.z = -LOG2E * (excl + v[i + 2]); o4.w = -LOG2E * (excl + v[i + 3]); *(f32x4*)(cb + i) = o4; }
}

namespace attn {
constexpr int KPL = 2064;
constexpr int VPL = 8256;
constexpr int OFF_V = 8 * KPL;
constexpr int OFF_B = OFF_V + 2 * VPL;
constexpr int BUF = OFF_B + 512;
constexpr int NBUF = 3;
constexpr int OFF_WS = NBUF * BUF;
constexpr int OFF_ST = OFF_WS + 8 * 256;
constexpr int ST_BYTES = 32 * 144;
static_assert(OFF_ST + 8 * ST_BYTES <= LDS_BYTES - 256, "attention LDS map");

struct Item { int valid, type, b, h, qcol, kcol, vcol, zcol, ycol, dil, res0, M0, c0, c1, W; };

__device__ __forceinline__ Item make_item(int sub, int g, int j) {
    Item it; it.valid = 0; it.type = 0; it.b = 0; it.h = 0; it.qcol = 0; it.kcol = 0; it.vcol = 0; it.zcol = 0; it.ycol = 0; it.dil = 1; it.res0 = 0; it.M0 = 0; it.c0 = 0; it.c1 = 1; it.W = 128;
    if (sub == 0) {
        if (j >= 8) return it;
        it.valid = 1;
        if (j < 2) {
            const int bh = g >> 2, s = g & 3, qb = j == 0 ? s : 7 - s, h = bh & 3;
            it.type = 0; it.b = bh >> 2; it.h = h; it.qcol = 64 * h; it.kcol = 256 + 64 * h; it.vcol = 512 + 64 * h; it.zcol = 768 + 64 * h; it.ycol = 64 * h;
            it.M0 = 256 * qb; it.c0 = 0; it.c1 = 2 * (qb + 1); it.W = 1 << 30; return it;
        }
        const bool isC = j >= 5; const int idx = g * 3 + (j - (isC ? 5 : 2)), b = idx / 48, rem = idx % 48, h = rem >> 3, blk = rem & 7;
        it.b = b; it.h = h; it.M0 = 256 * blk; it.c0 = blk == 0 ? 1 : 0; it.c1 = 3;
        const int kvh = h / 3;
        it.type = isC ? 4 : 1; it.qcol = (isC ? 2560 : 1024) + 64 * h; it.kcol = isC ? 2944 + 64 * kvh : 1408 + 64 * h; it.vcol = isC ? 3072 + 64 * kvh : 1792 + 64 * h;
        it.zcol = (isC ? 3200 : 2176) + 64 * h; it.ycol = (isC ? 640 : 256) + 64 * h; it.W = isC ? 127 : 128;
        return it;
    }
    if (j >= 3) return it;
    it.valid = 1;
    const int idx = g * 3 + j, b = idx / 48, rem = idx % 48, h = rem >> 3, r8 = rem & 7;
    it.b = b; it.h = h; it.qcol = 1024 + 64 * h; it.kcol = 1408 + 64 * h; it.vcol = 1792 + 64 * h; it.zcol = 2176 + 64 * h; it.ycol = 256 + 64 * h; it.W = 128;
    const int blk = r8 & 1;
    it.type = sub == 1 ? 2 : 3; it.dil = sub == 1 ? 4 : 16; it.res0 = sub == 1 ? (r8 >> 1) : 2 * r8; it.M0 = sub == 1 ? 256 * blk : 0; it.c0 = (sub == 1 && blk == 0) ? 1 : 0; it.c1 = sub == 1 ? 3 : 2;
    return it;
}
__device__ __forceinline__ void chunk_src(const Item& it, int c, int& kp0, int& kres) {
    if (it.type == 0) { kp0 = 128 * c; kres = 0; }
    else if (it.type == 3) { kp0 = 0; kres = it.res0 + c; }
    else { kp0 = it.M0 - 128 + 128 * c; kres = it.res0; }
}
__device__ __forceinline__ s16x4 vtr(LAS const unsigned char* p) {
    typedef short v4i16_t __attribute__((ext_vector_type(4)));
    return __builtin_bit_cast(s16x4, __builtin_amdgcn_ds_read_tr16_b64_v4i16((LAS v4i16_t*)p));
}

__device__ __forceinline__ void attn_phase(const Args& a, int layer, int sub, LAS unsigned char* lds, int g) {
    int tid_ = threadIdx.x; asm volatile("" : "+v"(tid_));
    const int tid = tid_, lane = tid & 63, w = __builtin_amdgcn_readfirstlane(tid >> 6), hi = lane >> 5, l31 = lane & 31;
    const bf16_t* QKVZ = (const bf16_t*)(a.ws + WS_QKVZ); bf16_t* Y = (bf16_t*)(a.ws + WS_H); float* LSE = (float*)(a.ws + WS_LSE); const float* CB = (const float*)(a.ws + WS_CB);
    LAS float* wsf = (LAS float*)(lds + OFF_WS + w * 256);
    LAS bf16_t* stg = (LAS bf16_t*)(lds + OFF_ST + w * ST_BYTES);
    int j = 0, cb;
    { const Item it0 = make_item(sub, g, 0); if (!it0.valid) return; cb = it0.c0; }
    u32x4 kreg[NBUF][2], vreg[NBUF][2]; float breg[NBUF]; bf16x8 qn[4];
#define ATT_ISSUE(IT, CBEG, NCH) do { _Pragma("unroll") for (int ci_ = 0; ci_ < NBUF; ++ci_) if (ci_ < (NCH)) { int kp0_, kres_; chunk_src(IT, (CBEG) + ci_, kp0_, kres_); \
        _Pragma("unroll") for (int i_ = 0; i_ < 2; ++i_) { const int p_ = tid + 512 * i_, key_ = p_ >> 3, c16_ = p_ & 7; int m_ = kp0_ + key_; m_ = m_ < 0 ? 0 : m_; \
            const bf16_t* rp_ = QKVZ + (size_t)((IT).b * SEQ + m_ * (IT).dil + kres_) * NQ + c16_ * 8; \
            kreg[ci_][i_] = *(const u32x4*)(rp_ + (IT).kcol); vreg[ci_][i_] = *(const u32x4*)(rp_ + (IT).vcol); } \
        breg[ci_] = CB[(size_t)((IT).b * 4 + ((IT).h & 3)) * SEQ + ((kp0_ + (tid & 127)) & (SEQ - 1))]; } \
        if ((CBEG) == (IT).c0) { const int qres_ = (IT).type == 3 ? (IT).res0 + (w >> 2) : (IT).res0, mq0_ = (IT).type == 3 ? 32 * (w & 3) : (IT).M0 + 32 * w; \
            const bf16_t* qp_ = QKVZ + (size_t)((IT).b * SEQ + (mq0_ + l31) * (IT).dil + qres_) * NQ + (IT).qcol + 8 * hi; \
            _Pragma("unroll") for (int s_ = 0; s_ < 4; ++s_) qn[s_] = __builtin_nontemporal_load((const bf16x8*)(qp_ + 16 * s_)); } } while (0)
    { const Item it0 = make_item(sub, g, 0); const int n0 = it0.c1 - cb < NBUF ? it0.c1 - cb : NBUF; ATT_ISSUE(it0, cb, n0); }
    bf16x8 qf[4]; f32x16 o0, o1; float mrun = -1e30f, lrun = 0.f;
    for (;;) {
        const Item it = make_item(sub, g, j);
        const int nch = it.c1 - cb < NBUF ? it.c1 - cb : NBUF;
        int ncb = cb + nch, nj = j;
        if (ncb >= it.c1) nj = j + 1;
        const Item nx = make_item(sub, g, nj);
        const bool has_next = nx.valid != 0;
        if (nj != j) ncb = nx.c0;
        const int nnch = nx.c1 - ncb < NBUF ? nx.c1 - ncb : NBUF;
        __syncthreads();
#pragma unroll
        for (int ci = 0; ci < NBUF; ++ci) if (ci < nch) {
            LAS unsigned char* wb = lds + ci * BUF;
#pragma unroll
            for (int i = 0; i < 2; ++i) { const int p = tid + 512 * i, key = p >> 3, c16 = p & 7;
                *(LAS u32x4*)(wb + c16 * KPL + key * 16) = kreg[ci][i];
                *(LAS u32x4*)(wb + OFF_V + (c16 >> 2) * VPL + (key >> 3) * 512 + (key & 7) * 64 + (c16 & 3) * 16) = vreg[ci][i]; }
            if (tid < 128) *(LAS float*)(wb + OFF_B + tid * 4) = breg[ci];
        }
        __syncthreads();
        const int qres = it.type == 3 ? it.res0 + (w >> 2) : it.res0;
        const int mq0 = it.type == 3 ? 32 * (w & 3) : it.M0 + 32 * w;
        if (cb == it.c0) {
#pragma unroll
            for (int s = 0; s < 4; ++s) qf[s] = qn[s];
        }
        if (has_next) ATT_ISSUE(nx, ncb, nnch);
        if (cb == it.c0) {
#pragma unroll
            for (int r = 0; r < 16; ++r) { o0[r] = 0.f; o1[r] = 0.f; }
            mrun = -1e30f; lrun = 0.f;
        }
#pragma unroll 1
        for (int ci = 0; ci < nch; ++ci) {
        const int c = cb + ci;
        LAS unsigned char* buf = lds + ci * BUF;
        int kp0, kres; chunk_src(it, c, kp0, kres);
        if (kres == qres) {
#pragma unroll 1
            for (int jp = 0; jp < 2; ++jp) {
                const int a0 = kp0 + 64 * jp;
                if (a0 > mq0 + 31 || a0 + 63 < mq0 - it.W || a0 + 63 < 0) continue;
                const bool needmask = !(a0 + 63 <= mq0 && a0 >= mq0 + 31 - it.W && a0 >= 0);
                LAS const unsigned char* kb = buf + hi * KPL + (64 * jp + l31) * 16;
                const bf16x8 kf0 = *(LAS const bf16x8*)(kb), kf1 = *(LAS const bf16x8*)(kb + 2 * KPL), kf2 = *(LAS const bf16x8*)(kb + 4 * KPL), kf3 = *(LAS const bf16x8*)(kb + 6 * KPL);
                const bf16x8 kg0 = *(LAS const bf16x8*)(kb + 512), kg1 = *(LAS const bf16x8*)(kb + 512 + 2 * KPL), kg2 = *(LAS const bf16x8*)(kb + 512 + 4 * KPL), kg3 = *(LAS const bf16x8*)(kb + 512 + 6 * KPL);
                f32x16 s, t;
                if (it.type == 0) {
#pragma unroll
                    for (int g4 = 0; g4 < 4; ++g4) { const f32x4 bv = *(LAS const f32x4*)(buf + OFF_B + (64 * jp + 8 * g4 + 4 * hi) * 4), bw = *(LAS const f32x4*)(buf + OFF_B + (64 * jp + 32 + 8 * g4 + 4 * hi) * 4);
                        s[4 * g4] = bv.x; s[4 * g4 + 1] = bv.y; s[4 * g4 + 2] = bv.z; s[4 * g4 + 3] = bv.w; t[4 * g4] = bw.x; t[4 * g4 + 1] = bw.y; t[4 * g4 + 2] = bw.z; t[4 * g4 + 3] = bw.w; }
                    s = __builtin_amdgcn_mfma_f32_32x32x16_bf16(kf0, qf[0], s, 0, 0, 0);
                    t = __builtin_amdgcn_mfma_f32_32x32x16_bf16(kg0, qf[0], t, 0, 0, 0);
                } else {
                    const f32x16 z16 = {0.f, 0.f, 0.f, 0.f, 0.f, 0.f, 0.f, 0.f, 0.f, 0.f, 0.f, 0.f, 0.f, 0.f, 0.f, 0.f};
                    s = __builtin_amdgcn_mfma_f32_32x32x16_bf16(kf0, qf[0], z16, 0, 0, 0);
                    t = __builtin_amdgcn_mfma_f32_32x32x16_bf16(kg0, qf[0], z16, 0, 0, 0);
                }
                s = __builtin_amdgcn_mfma_f32_32x32x16_bf16(kf1, qf[1], s, 0, 0, 0);
                t = __builtin_amdgcn_mfma_f32_32x32x16_bf16(kg1, qf[1], t, 0, 0, 0);
                s = __builtin_amdgcn_mfma_f32_32x32x16_bf16(kf2, qf[2], s, 0, 0, 0);
                t = __builtin_amdgcn_mfma_f32_32x32x16_bf16(kg2, qf[2], t, 0, 0, 0);
                s = __builtin_amdgcn_mfma_f32_32x32x16_bf16(kf3, qf[3], s, 0, 0, 0);
                t = __builtin_amdgcn_mfma_f32_32x32x16_bf16(kg3, qf[3], t, 0, 0, 0);
                LAS const unsigned char* vb = buf + OFF_V + (8 * jp) * 512 + (4 * hi + ((lane & 15) >> 2)) * 64 + ((lane >> 4) & 1) * 32 + (lane & 3) * 8;
#define ATT_VF(cc, ks) ({ const s16x4 lo_ = vtr(vb + (cc) * VPL + (2 * (ks)) * 512), hi_ = vtr(vb + (cc) * VPL + (2 * (ks) + 1) * 512); (bf16x8){lo_[0], lo_[1], lo_[2], lo_[3], hi_[0], hi_[1], hi_[2], hi_[3]}; })
                const bf16x8 v00 = ATT_VF(0, 0), v01 = ATT_VF(0, 1), v02 = ATT_VF(0, 2), v03 = ATT_VF(0, 3), v10 = ATT_VF(1, 0), v11 = ATT_VF(1, 1), v12 = ATT_VF(1, 2), v13 = ATT_VF(1, 3);
#undef ATT_VF
                if (needmask) {
                    const int qpos = mq0 + l31;
#pragma unroll
                    for (int r = 0; r < 16; ++r) { const int kpos = a0 + (r & 3) + 8 * (r >> 2) + 4 * hi; const bool ok = kpos >= 0 && kpos <= qpos && qpos - kpos <= it.W; s[r] = ok ? s[r] : -INFINITY;
                        const int kp2 = kpos + 32; const bool ok2 = kp2 >= 0 && kp2 <= qpos && qpos - kp2 <= it.W; t[r] = ok2 ? t[r] : -INFINITY; }
                }
                float mx = __builtin_fmaxf(__builtin_fmaxf(s[0], s[1]), t[0]), my = __builtin_fmaxf(__builtin_fmaxf(s[2], s[3]), t[1]);
                mx = __builtin_fmaxf(__builtin_fmaxf(mx, t[2]), t[3]);
#pragma unroll
                for (int r = 4; r < 16; r += 4) { mx = __builtin_fmaxf(__builtin_fmaxf(mx, s[r]), s[r + 1]); my = __builtin_fmaxf(__builtin_fmaxf(my, s[r + 2]), s[r + 3]); mx = __builtin_fmaxf(__builtin_fmaxf(mx, t[r]), t[r + 1]); my = __builtin_fmaxf(__builtin_fmaxf(my, t[r + 2]), t[r + 3]); }
                mx = __builtin_fmaxf(mx, my);
                { const auto rr = __builtin_amdgcn_permlane32_swap(__float_as_uint(mx), __float_as_uint(mx), false, false); mx = fmaxf(__uint_as_float(rr[0]), __uint_as_float(rr[1])); }
                const float mnew = fmaxf(mrun, mx);
                if (__any(mx > mrun + 16.0f)) {
                    const float alpha = ex2(mrun - mnew); lrun *= alpha; mrun = mnew;
                    if (hi == 0) wsf[l31] = alpha;
#pragma unroll
                    for (int g4 = 0; g4 < 4; ++g4) { const f32x4 av = *(LAS const f32x4*)(wsf + 8 * g4 + 4 * hi);
                        o0[4 * g4] *= av.x; o0[4 * g4 + 1] *= av.y; o0[4 * g4 + 2] *= av.z; o0[4 * g4 + 3] *= av.w;
                        o1[4 * g4] *= av.x; o1[4 * g4 + 1] *= av.y; o1[4 * g4 + 2] *= av.z; o1[4 * g4 + 3] *= av.w; }
                }
                float ps = 0.f, pt = 0.f;
#pragma unroll
                for (int r = 0; r < 16; ++r) { s[r] = ex2(s[r] - mrun); ps += s[r]; t[r] = ex2(t[r] - mrun); pt += t[r]; }
                lrun += ps + pt;
                u32x4 pw0, pw1, pw2, pw3;
                pw0.x = pk2(s[0], s[1]); pw0.y = pk2(s[2], s[3]); pw0.z = pk2(s[4], s[5]); pw0.w = pk2(s[6], s[7]);
                pw1.x = pk2(s[8], s[9]); pw1.y = pk2(s[10], s[11]); pw1.z = pk2(s[12], s[13]); pw1.w = pk2(s[14], s[15]);
                pw2.x = pk2(t[0], t[1]); pw2.y = pk2(t[2], t[3]); pw2.z = pk2(t[4], t[5]); pw2.w = pk2(t[6], t[7]);
                pw3.x = pk2(t[8], t[9]); pw3.y = pk2(t[10], t[11]); pw3.z = pk2(t[12], t[13]); pw3.w = pk2(t[14], t[15]);
                const bf16x8 pa0 = __builtin_bit_cast(bf16x8, pw0), pa1 = __builtin_bit_cast(bf16x8, pw1), pa2 = __builtin_bit_cast(bf16x8, pw2), pa3 = __builtin_bit_cast(bf16x8, pw3);
                o0 = __builtin_amdgcn_mfma_f32_32x32x16_bf16(pa0, v00, o0, 0, 0, 0);
                o1 = __builtin_amdgcn_mfma_f32_32x32x16_bf16(pa0, v10, o1, 0, 0, 0);
                o0 = __builtin_amdgcn_mfma_f32_32x32x16_bf16(pa1, v01, o0, 0, 0, 0);
                o1 = __builtin_amdgcn_mfma_f32_32x32x16_bf16(pa1, v11, o1, 0, 0, 0);
                o0 = __builtin_amdgcn_mfma_f32_32x32x16_bf16(pa2, v02, o0, 0, 0, 0);
                o1 = __builtin_amdgcn_mfma_f32_32x32x16_bf16(pa2, v12, o1, 0, 0, 0);
                o0 = __builtin_amdgcn_mfma_f32_32x32x16_bf16(pa3, v03, o0, 0, 0, 0);
                o1 = __builtin_amdgcn_mfma_f32_32x32x16_bf16(pa3, v13, o1, 0, 0, 0);
            }
        }
        }
        if (cb + nch == it.c1) {
            float lt; { const auto rr = __builtin_amdgcn_permlane32_swap(__float_as_uint(lrun), __float_as_uint(lrun), false, false); lt = __uint_as_float(rr[0]) + __uint_as_float(rr[1]); }
            float scale, L2 = 0.f;
            if (it.type == 4) { const float sink2 = a.sinks[layer * 6 + it.h] * LOG2E, mf = fmaxf(mrun, sink2), al = ex2(mrun - mf); scale = al / (lt * al + ex2(sink2 - mf)); }
            else { scale = 1.f / lt; L2 = mrun + log2f(lt); }
            if (hi == 0) { wsf[l31] = scale; wsf[32 + l31] = L2; }
#pragma unroll
            for (int g4 = 0; g4 < 4; ++g4) { const f32x4 av = *(LAS const f32x4*)(wsf + 8 * g4 + 4 * hi);
#pragma unroll
                for (int e = 0; e < 4; ++e) { const int r = 4 * g4 + e, row = 8 * g4 + 4 * hi + e;
                    stg[row * 72 + l31] = (bf16_t)f2bf(o0[r] * av[e]); stg[row * 72 + 32 + l31] = (bf16_t)f2bf(o1[r] * av[e]); } }
#pragma unroll
            for (int i = 0; i < 4; ++i) {
                const int row = i * 8 + (lane >> 3), ch = lane & 7;
                const u32x4 ov = *(LAS const u32x4*)(stg + row * 72 + ch * 8);
                const size_t tok = (size_t)(it.b * SEQ + (mq0 + row) * it.dil + qres);
                bf16_t* yp = Y + tok * 1024 + it.ycol + ch * 8;
                float f[8] = {bflo(ov.x), bfhi(ov.x), bflo(ov.y), bfhi(ov.y), bflo(ov.z), bfhi(ov.z), bflo(ov.w), bfhi(ov.w)};
                if (it.type == 1) { if (ch == 0) LSE[tok * 6 + it.h] = wsf[32 + row]; }
                if (it.type == 2 || it.type == 3) {
                    const u32x4 od = *(const u32x4*)yp; const float Lold = LSE[tok * 6 + it.h], Lnew = wsf[32 + row], Lm = fmaxf(Lold, Lnew);
                    float wo = ex2(Lold - Lm), wn = ex2(Lnew - Lm); const float sw = wo + wn, inv = 1.f / sw; wo *= inv; wn *= inv;
                    const float q[8] = {bflo(od.x), bfhi(od.x), bflo(od.y), bfhi(od.y), bflo(od.z), bfhi(od.z), bflo(od.w), bfhi(od.w)};
#pragma unroll
                    for (int e = 0; e < 8; ++e) f[e] = wo * q[e] + wn * f[e];
                    if (it.type == 2 && ch == 0) LSE[tok * 6 + it.h] = Lm + log2f(sw);
                }
                if (it.type == 0 || it.type >= 3) {
                    const u32x4 zv = __builtin_nontemporal_load((const u32x4*)(QKVZ + tok * NQ + it.zcol + ch * 8));
                    const float z[8] = {bflo(zv.x), bfhi(zv.x), bflo(zv.y), bfhi(zv.y), bflo(zv.z), bfhi(zv.z), bflo(zv.w), bfhi(zv.w)};
#pragma unroll
                    for (int e = 0; e < 8; ++e) f[e] *= z[e];
                }
                u32x4 wv; wv.x = pk2(f[0], f[1]); wv.y = pk2(f[2], f[3]); wv.z = pk2(f[4], f[5]); wv.w = pk2(f[6], f[7]);
                *(u32x4*)yp = wv;
            }
        }
        if (!has_next) break;
        cb = ncb; j = nj;
    }
#undef ATT_ISSUE
}
}

__device__ __forceinline__ void final_norm_phase(const Args& a, int vcu, int G) {
    int tid_ = threadIdx.x; asm volatile("" : "+v"(tid_));
    const int tid = tid_, lane = tid & 63, wave = tid >> 6, gw = vcu * 8 + wave, NGW = G * 8;
    f32x4 gv[4];
#pragma unroll
    for (int j = 0; j < 4; ++j) gv[j] = *(const f32x4*)(a.final_g + 256 * j + 4 * lane);
    for (int m = gw; m < M; m += NGW) {
        f32x4* xr = (f32x4*)(a.out + (size_t)m * D) + lane;
        f32x4 v[4]; float s2 = 0.f;
#pragma unroll
        for (int j = 0; j < 4; ++j) { v[j] = xr[64 * j]; s2 += (v[j].x * v[j].x + v[j].y * v[j].y) + (v[j].z * v[j].z + v[j].w * v[j].w); }
        const float rs = 1.0f / sqrtf(wave_sum(s2, lane) * (1.f / D) + RMS_EPS);
#pragma unroll
        for (int j = 0; j < 4; ++j) xr[64 * j] = v[j] * rs * gv[j];
    }
}


#define XB_TMO      128
#define XB_XCNT(j)  (256  + 64 * (j))
#define XB_XSUB(j)  (1280 + 64 * (j))
#define XB_XGEN(j)  (2304 + 64 * (j))
#define XB_TOP      3328
#define XB_TOPGEN   3392
#define XCD_BAR_WORDS 3456
#define XB_SPIN_CAP (1u << 18)
__device__ __forceinline__ unsigned xb_ld(unsigned* p)              { return __hip_atomic_load(p, __ATOMIC_RELAXED, __HIP_MEMORY_SCOPE_AGENT); }
__device__ __forceinline__ unsigned xb_add(unsigned* p, unsigned v) { return __hip_atomic_fetch_add(p, v, __ATOMIC_RELAXED, __HIP_MEMORY_SCOPE_AGENT); }
__device__ __forceinline__ unsigned xb_xcc_id() { return (unsigned)__builtin_amdgcn_s_getreg((3 << 11) | 20) & 0xFu; }
#define XB_SPIN(cond, bar) do { unsigned _sp = 0; while (cond) { __builtin_amdgcn_s_sleep(1); \
    if ((++_sp & 255u) == 0u) { if (xb_ld(&(bar)[XB_TMO])) break; if (_sp > XB_SPIN_CAP) { atomicAdd(&(bar)[XB_TMO], 1u); break; } } } } while (0)
struct XcdBarrier { unsigned* bar; unsigned x; volatile LAS unsigned* st; };
__device__ __forceinline__ XcdBarrier xcd_barrier_post(unsigned* bar, volatile LAS unsigned* st) {
    XcdBarrier b; b.bar = bar; b.x = xb_xcc_id(); b.st = st;
    if (threadIdx.x == 0) (void)xb_add(&bar[XB_XCNT(b.x)], 1u);
    return b;
}
__device__ __forceinline__ void xcd_barrier_complete(unsigned* bar, unsigned x, unsigned& nloc, unsigned& nx) {
    const unsigned G = gridDim.x * gridDim.y * gridDim.z;
    unsigned sum, cnt, mine, sp = 0u;
    for (;;) {
        sum = 0u; cnt = 0u; mine = 0u;
#pragma unroll
        for (unsigned j = 0; j < 16; ++j) { const unsigned c = xb_ld(&bar[XB_XCNT(j)]); sum += c; cnt += (c > 0u) ? 1u : 0u; mine = (j == x) ? c : mine; }
        if (sum == G) break;
        __builtin_amdgcn_s_sleep(1);
        if ((++sp & 255u) == 0u) { if (xb_ld(&bar[XB_TMO])) break; if (sp > XB_SPIN_CAP) { atomicAdd(&bar[XB_TMO], 1u); break; } }
    }
    nloc = mine > 0u ? mine : 1u; nx = cnt > 0u ? cnt : 1u;
}
__device__ __forceinline__ void xcd_barrier(const XcdBarrier& b) {
    asm volatile("s_waitcnt vmcnt(0)" ::: "memory");
    __syncthreads();
    if (threadIdx.x == 0) {
        unsigned* bar = b.bar;
        __builtin_amdgcn_s_waitcnt(0);
        unsigned nloc = b.st[0], nx = b.st[1];
        if (nloc == 0u) { xcd_barrier_complete(bar, b.x, nloc, nx); b.st[0] = nloc; b.st[1] = nx; }
        const unsigned old = xb_add(&bar[XB_XSUB(b.x)], 1u);
        const unsigned gen = old / nloc;
        if (old + 1u == (gen + 1u) * nloc) {
            __builtin_amdgcn_fence(__ATOMIC_RELEASE, "agent");
            asm volatile("s_waitcnt vmcnt(0)" ::: "memory");
            const unsigned og = xb_add(&bar[XB_TOP], 1u);
            const unsigned tg = og / nx;
            if (og + 1u == (tg + 1u) * nx) xb_add(&bar[XB_TOPGEN], 1u);
            else XB_SPIN(xb_ld(&bar[XB_TOPGEN]) == tg, bar);
            __builtin_amdgcn_fence(__ATOMIC_ACQUIRE, "agent");
            xb_add(&bar[XB_XGEN(b.x)], 1u);
            asm volatile("s_waitcnt vmcnt(0)" ::: "memory");
        } else {
            XB_SPIN(xb_ld(&bar[XB_XGEN(b.x)]) == gen, bar);
            __builtin_amdgcn_fence(__ATOMIC_ACQUIRE, "agent");
            asm volatile("s_waitcnt vmcnt(0)" ::: "memory");
        }
    }
    __syncthreads();
}

__global__ void __launch_bounds__(NTHREADS, 2) fwd_megakernel(Args a) {
    extern __shared__ __attribute__((aligned(16))) unsigned char lds_raw[];
    cg::grid_group grid = cg::this_grid();
    LAS unsigned char* lds = (LAS unsigned char*)lds_raw;
    const int G = gridDim.x, bx = blockIdx.x;
    const int vcu = (G % 8 == 0) ? (bx % 8) * (G / 8) + bx / 8 : bx;
    unsigned char* ws = a.ws;
    if (ws == nullptr) grid.sync();
    volatile LAS unsigned* bst = (volatile LAS unsigned*)(lds + LDS_BYTES - 64);
    if (threadIdx.x < 2) bst[threadIdx.x] = 0u;
    __syncthreads();
    const XcdBarrier bar = xcd_barrier_post((unsigned*)ws, bst);
#pragma unroll 1
    for (int step = 0; step < 14; ++step) {
        const int layer = step / 7, ph = step - 7 * layer;
#ifndef NO_PREP
        if (ph == 0) { for (int rep = 0; rep < PROBE_REP_PREP; ++rep) prep_phase(a, layer, lds, vcu, G); }
        else
#endif
        if (ph == 1 || ph >= 5) {
#ifndef NO_GEMM
            if (ph == 1) cumsum_phase(a, bx);
            pg8::Sched S; S.kind = ph == 1 ? 0 : (ph == 5 ? 1 : 2); S.so.init(M, ph == 1 ? NP : 1024, G, bx);
            pg8::Epi E; E.QKVZ = (bf16_t*)(ws + WS_QKVZ); E.Gt = (bf16_t*)(ws + WS_G); E.MERGED = (bf16_t*)(ws + WS_QKVZ);
            E.xin = layer == 0 ? a.x : a.out; E.xout = a.out; E.cosT = (const float*)(ws + WS_COS); E.sinT = (const float*)(ws + WS_SIN);
            E.gfin = layer == 0 ? a.norm_g + D : a.final_g; E.Hout = (bf16_t*)(ws + WS_H); E.slots = (unsigned*)(ws + WS_SLOTS); E.cnt = (unsigned*)(ws + 16384 + layer * 32768); E.xl = lds + 131072;
            const bf16_t* A = ph == 1 ? (const bf16_t*)(ws + WS_H) : (ph == 5 ? (const bf16_t*)(ws + WS_H) : (const bf16_t*)(ws + WS_QKVZ));
            const bf16_t* Bt = ph == 1 ? (const bf16_t*)(ws + WS_WIN) : (ph == 5 ? (const bf16_t*)(ws + WS_WBR) : (const bf16_t*)(ws + WS_WOUT));
#ifdef ONLY_KIND
            pg8::gemm_phase<ONLY_KIND>(lds, A, Bt, S, E);
#else
            if (ph == 1) { for (int rep = 0; rep < PROBE_REP_GEMM1; ++rep) pg8::gemm_phase<0>(lds, A, Bt, S, E); } else if (ph == 5) { for (int rep = 0; rep < PROBE_REP_MERGE; ++rep) pg8::gemm_phase<1>(lds, A, Bt, S, E); } else if (layer == 0) pg8::gemm_phase<4>(lds, A, Bt, S, E); else pg8::gemm_phase<3>(lds, A, Bt, S, E);
#endif
#endif
        }
#ifndef NO_ATTN
        else { const int nrep = ph == 2 ? PROBE_REP_ATT0 : 1; for (int rep = 0; rep < nrep; ++rep) { attn::attn_phase(a, layer, ph - 2, lds, vcu); __syncthreads(); } }
#endif
        if (step == 13) break;
        xcd_barrier(bar);
#ifdef PROBE_SYNC2
        xcd_barrier(bar);
#endif
    }
}

extern "C" void kernel_launch(void* const* d_in, const int* in_sizes, int n_in, void* d_out, int out_size, void* d_ws, size_t ws_size, hipStream_t stream) {
    static int grid = 0;
    if (grid == 0) {
        if (n_in != 10 || in_sizes[0] != M * D || out_size != M * D || ws_size < WS_END) { fprintf(stderr, "kernel_launch: unexpected shapes/workspace (n_in %d, in0 %d, out %d, ws %zu)\n", n_in, n_in > 0 ? in_sizes[0] : -1, out_size, ws_size); grid = -1; return; }
        int dev = 0, cus = 0, per_cu = 0;
        if (hipGetDevice(&dev) != hipSuccess || hipDeviceGetAttribute(&cus, hipDeviceAttributeMultiprocessorCount, dev) != hipSuccess) { grid = -1; return; }
        if (hipFuncSetAttribute((const void*)fwd_megakernel, hipFuncAttributeMaxDynamicSharedMemorySize, LDS_BYTES) != hipSuccess) { fprintf(stderr, "kernel_launch: hipFuncSetAttribute failed\n"); grid = -1; return; }
        if (hipOccupancyMaxActiveBlocksPerMultiprocessor(&per_cu, (const void*)fwd_megakernel, NTHREADS, LDS_BYTES) != hipSuccess || per_cu < 1) { fprintf(stderr, "kernel_launch: occupancy query gave %d\n", per_cu); (void)hipGetLastError(); per_cu = 1; }
        grid = cus * (per_cu > 1 ? 1 : per_cu);
    }
    if (grid < 0) return;
    if (hipMemsetAsync(d_ws, 0, 131072, stream) != hipSuccess) { fprintf(stderr, "kernel_launch: memset of barrier words failed\n"); return; }
    Args a{};
    a.x = (const float*)d_in[0]; a.norm_g = (const float*)d_in[1]; a.w_in = (const float*)d_in[2]; a.b_forget = (const float*)d_in[3]; a.sinks = (const float*)d_in[4];
    a.w_br_a = (const float*)d_in[5]; a.w_br_b = (const float*)d_in[6]; a.w_br_c = (const float*)d_in[7]; a.w_out = (const float*)d_in[8]; a.final_g = (const float*)d_in[9];
    a.out = (float*)d_out; a.ws = (unsigned char*)d_ws;
    for (int i = 0; i < 32; ++i) a.inv_freq[i] = powf(10000.0f, -(float)(2 * i) / 64.0f);
    void* args[] = {&a};
    hipError_t e = hipLaunchCooperativeKernel((const void*)fwd_megakernel, dim3(grid), dim3(NTHREADS), args, LDS_BYTES, stream);
    if (e != hipSuccess) fprintf(stderr, "kernel_launch: cooperative launch failed: %s (grid %d)\n", hipGetErrorString(e), grid);
}
```

```cpp
#include <hip/hip_runtime.h>
#include <hip/hip_cooperative_groups.h>
#include <cstdio>
#include <cstdint>
#include <cmath>
namespace cg = cooperative_groups;

#define LAS __attribute__((address_space(3)))
#define GAS __attribute__((address_space(1)))
typedef unsigned short bf16_t;
typedef short bf16x8 __attribute__((ext_vector_type(8)));
typedef short s16x4 __attribute__((ext_vector_type(4)));
typedef float f32x4 __attribute__((ext_vector_type(4)));
typedef float f32x16 __attribute__((ext_vector_type(16)));
typedef unsigned u32x4 __attribute__((ext_vector_type(4)));
typedef unsigned u32x2 __attribute__((ext_vector_type(2)));

constexpr int SEQ = 2048, NBATCH = 16, M = NBATCH * SEQ, D = 1024;
constexpr int NIN = 6660;
constexpr int NP = 6656;
constexpr int NQ = 3584;
constexpr int NGC = 3072;
constexpr float LOG2E = 1.4426950408889634f;
constexpr float C2 = 0.125f * LOG2E;
constexpr float RMS_EPS = 1e-6f;

constexpr size_t MiB = 1u << 20;
constexpr size_t WS_COS = 1 * MiB;
constexpr size_t WS_SIN = WS_COS + 256 * 1024;
constexpr size_t WS_LOGF = WS_SIN + 256 * 1024;
constexpr size_t WS_CB = WS_LOGF + 512 * 1024;
constexpr size_t WS_LSE = WS_CB + 512 * 1024;
constexpr size_t WS_SLOTS = 512 * 1024;
constexpr size_t WS_WIN = 4 * MiB;
constexpr size_t WS_WBR = 17 * MiB;
constexpr size_t WS_WOUT = 19 * MiB;
constexpr size_t WS_H = 22 * MiB;
constexpr size_t WS_QKVZ = 86 * MiB;
constexpr size_t WS_G = 310 * MiB;
constexpr size_t WS_END = 502 * MiB;

constexpr int LDS_BYTES = 147456;
constexpr int NTHREADS = 512;
#ifndef GEMM1_WGM
#define GEMM1_WGM 2
#endif
#ifndef PROBE_REP_GEMM1
#define PROBE_REP_GEMM1 1
#endif
#ifndef PROBE_REP_MERGE
#define PROBE_REP_MERGE 1
#endif
#ifndef PROBE_REP_PREP
#define PROBE_REP_PREP 1
#endif
#ifndef PROBE_REP_ATT0
#define PROBE_REP_ATT0 1
#endif

__device__ __forceinline__ unsigned f2bf(float f) { unsigned u = __builtin_bit_cast(unsigned, f); return (u + 0x7fffu + ((u >> 16) & 1u)) >> 16; }
typedef float f32x2_t __attribute__((ext_vector_type(2))); typedef __bf16 bf16x2_t __attribute__((ext_vector_type(2)));
__device__ __forceinline__ unsigned pk2(float lo, float hi) { f32x2_t v = {lo, hi}; bf16x2_t b = __builtin_convertvector(v, bf16x2_t); return __builtin_bit_cast(unsigned, b); }
__device__ __forceinline__ float bflo(unsigned w) { return __builtin_bit_cast(float, w << 16); }
__device__ __forceinline__ float bfhi(unsigned w) { return __builtin_bit_cast(float, w & 0xffff0000u); }
__device__ __forceinline__ float ex2(float x) { return __builtin_amdgcn_exp2f(x); }
__device__ __forceinline__ float rcpf_(float x) { return __builtin_amdgcn_rcpf(x); }
__device__ __forceinline__ float bperm(float v, int src_lane) { return __builtin_bit_cast(float, __builtin_amdgcn_ds_bpermute(src_lane << 2, __builtin_bit_cast(int, v))); }

namespace pg8 {
constexpr int BM = 256, BK = 64, HALF = 128, HTB = HALF * BK * 2, STAGE_BYTES = 8 * HTB, NXCD = 8, WGM = 8, LD = 1024;
__device__ __forceinline__ int lds_byte(int r, int c) { const int st = (r >> 4) * 2 + (c >> 5), rr = r & 15, cc = c & 31, ob = rr * 64 + cc * 2; return st * 1024 + (ob ^ (((ob >> 9) & 1) << 5)); }
__device__ __forceinline__ void stage_rc(int b, int& R, int& C) { const int st = b / 1024, sb = b % 1024, swz = sb ^ (((sb >> 9) & 1) << 5); R = (st >> 1) * 16 + swz / 64; C = (st & 1) * 32 + (swz % 64) / 2; }
__device__ __forceinline__ int perm32(int rho) { const int n = rho >> 4, i = rho & 15; return 8 * (i >> 2) + 4 * n + (i & 3); }

struct Unit { int pm, pn, k0, nt, mode; };

struct StaticOrder {
    int nM, nN, nwg, G, c, wgm;
    __device__ void init(int M_, int N_, int G_, int c_, int wgm_ = WGM) { nM = M_ / BM; nN = N_ / BM; nwg = nM * nN; G = G_; c = c_; wgm = wgm_; }
    __device__ bool next(int i, Unit& u) const {
        const long L = (long)i * G + c; if (L >= nwg) return false;
        int wgid = (int)L; { const int q = nwg / NXCD, r = nwg % NXCD, xcd = wgid % NXCD, off = wgid / NXCD; wgid = (xcd < r ? xcd * (q + 1) : r * (q + 1) + (xcd - r) * q) + off; }
        const int nig = wgm * nN, gid = wgid / nig, fm = gid * wgm, gsz = (nM - fm) < wgm ? (nM - fm) : wgm;
        u.pm = fm + ((wgid % nig) % gsz); u.pn = (wgid % nig) / gsz; return true;
    }
};
struct Sched {
    StaticOrder so; int kind;
    __device__ bool next(int i, Unit& u) const {
        if (kind == 1) { const int t = i / 3, br = i - 3 * t; if (!so.next(t, u)) return false; u.k0 = br == 0 ? 0 : (br == 1 ? 256 : 640); u.nt = br == 0 ? 4 : 6; u.mode = 1 + br; return true; }
        if (!so.next(i, u)) return false; u.k0 = 0; u.nt = 16; u.mode = kind == 0 ? 0 : 4; return true;
    }
};

struct Epi {
    bf16_t* QKVZ; bf16_t* Gt; bf16_t* MERGED; const float* xin; float* xout; const float* cosT; const float* sinT;
    const float* gfin; bf16_t* Hout; unsigned* slots; unsigned* cnt; LAS unsigned char* xl;
    __device__ __forceinline__ static int blockop(int blk) {
        if (blk >= 28) return 3;
        if (blk < 8) return blk < 2 ? 1 : (blk < 6 ? 0 : 2);
        if (blk < 20) { const int t = blk - 8; return t < 3 ? 5 : (t < 6 ? 4 : (t < 9 ? 0 : 2)); }
        const int t = blk - 20; return t < 3 ? 5 : (t == 3 ? 4 : (t == 4 ? 0 : 2));
    }
    template <int KIND> __device__ __forceinline__ void run(f32x4 (&acc)[2][2][4][2], const Unit& u, int wr, int wc, int fr, int fq) const {
        const int rl = wr * 64 + fr, cl = wc * 32 + 8 * fq;
        if constexpr (KIND == 1) {
            const int br = u.mode - 1;
            const char* gbase = (const char*)(Gt + br * 1024 + u.pn * BM) + (size_t)u.pm * BM * NGC * 2;
            unsigned goff = (unsigned)(rl * NGC + cl) * 2u;
            const int gnext = br < 2 ? 2048 : 0;
            const bool rt = br < 2;
#pragma unroll
            for (int bj = 0; bj < 2; ++bj)
#pragma unroll
                for (int ai = 0; ai < 2; ++ai) {
                    u32x4 ga[4], gb[4];
#pragma unroll
                    for (int m = 0; m < 4; ++m) { const char* gp = gbase + (size_t)(ai * HALF + m * 16) * NGC * 2 + bj * 256 + goff; ga[m] = *(const u32x4*)gp; gb[m] = *(const u32x4*)(gp + gnext); }
#pragma unroll
                    for (int m = 0; m < 4; ++m) {
                        f32x4 f0, f1;
                        f0[0] = bflo(ga[m].x) * (rt ? rcpf_(bflo(gb[m].x)) : 1.f); f0[1] = bfhi(ga[m].x) * (rt ? rcpf_(bfhi(gb[m].x)) : 1.f); f0[2] = bflo(ga[m].y) * (rt ? rcpf_(bflo(gb[m].y)) : 1.f); f0[3] = bfhi(ga[m].y) * (rt ? rcpf_(bfhi(gb[m].y)) : 1.f);
                        f1[0] = bflo(ga[m].z) * (rt ? rcpf_(bflo(gb[m].z)) : 1.f); f1[1] = bfhi(ga[m].z) * (rt ? rcpf_(bfhi(gb[m].z)) : 1.f); f1[2] = bflo(ga[m].w) * (rt ? rcpf_(bflo(gb[m].w)) : 1.f); f1[3] = bfhi(ga[m].w) * (rt ? rcpf_(bfhi(gb[m].w)) : 1.f);
#define PKMUL_INPLACE(A, F) do { f32x2_t lo_ = {(A)[0], (A)[1]}, hi_ = {(A)[2], (A)[3]}; const f32x2_t fl_ = {(F)[0], (F)[1]}, fh_ = {(F)[2], (F)[3]}; \
        asm volatile("v_pk_mul_f32 %0, %0, %1" : "+v"(lo_) : "v"(fl_)); asm volatile("v_pk_mul_f32 %0, %0, %1" : "+v"(hi_) : "v"(fh_)); (A) = (f32x4){lo_[0], lo_[1], hi_[0], hi_[1]}; } while (0)
                        PKMUL_INPLACE(acc[ai][bj][m][0], f0); PKMUL_INPLACE(acc[ai][bj][m][1], f1);
                    }
                    asm volatile("" : "+v"(goff));
                }
            if (br == 2) {
                char* mbase = (char*)(MERGED + u.pn * BM) + (size_t)u.pm * BM * 1024 * 2;
                const unsigned moff = (unsigned)(rl * 1024 + cl) * 2u;
#pragma unroll
                for (int bj = 0; bj < 2; ++bj)
#pragma unroll
                    for (int ai = 0; ai < 2; ++ai)
#pragma unroll
                        for (int m = 0; m < 4; ++m) {
                            const f32x4 v0 = acc[ai][bj][m][0], v1 = acc[ai][bj][m][1];
                            u32x4 w; w.x = pk2(v0[0], v0[1]); w.y = pk2(v0[2], v0[3]); w.z = pk2(v1[0], v1[1]); w.w = pk2(v1[2], v1[3]);
                            *(u32x4*)(mbase + (size_t)(ai * HALF + m * 16) * 2048 + bj * 256 + moff) = w;
                        }
            }
            const float keep = br == 2 ? 0.f : 1.f;
#pragma unroll
            for (int bj = 0; bj < 2; ++bj)
#pragma unroll
                for (int ai = 0; ai < 2; ++ai)
#pragma unroll
                    for (int m = 0; m < 4; ++m) { const f32x4 k4 = (f32x4){keep, keep, keep, keep}; PKMUL_INPLACE(acc[ai][bj][m][0], k4); PKMUL_INPLACE(acc[ai][bj][m][1], k4); }
            return;
        }
        if constexpr (KIND == 0) {
            const unsigned toff = (unsigned)(rl * 32 + 16 * (wc & 1) + 4 * fq) * 4u;
            const char* cbase = (const char*)cosT + (size_t)((u.pm & 7) * 256) * 128; const char* sbase = (const char*)sinT + (size_t)((u.pm & 7) * 256) * 128;
#pragma unroll
            for (int bj = 0; bj < 2; ++bj) {
                const int blk = 2 * u.pn + bj, op = blockop(blk);
                const int ld = blk < 28 ? NQ : NGC;
                char* base = (char*)(blk < 28 ? QKVZ + blk * 128 : Gt + (blk - 28) * 128) + (size_t)u.pm * BM * ld * 2;
                const unsigned voff = (unsigned)(rl * ld + cl) * 2u;
                if (op >= 4) {
                    const float sc = op == 5 ? C2 : 1.f;
                    f32x4 c4[8], s4[8];
#pragma unroll
                    for (int q = 0; q < 8; ++q) { const int dr = (q >> 2) * HALF + (q & 3) * 16; c4[q] = *(const f32x4*)(cbase + dr * 128 + toff); s4[q] = *(const f32x4*)(sbase + dr * 128 + toff); }
                    asm volatile("" ::: "memory");
#pragma unroll
                    for (int q = 0; q < 8; ++q) {
                        const int ai = q >> 2, m = q & 3, dr = ai * HALF + m * 16;
                        const f32x4 v0 = acc[ai][bj][m][0], v1 = acc[ai][bj][m][1];
                        const f32x4 cc = c4[q] * sc, ss = s4[q] * sc;
                        u32x4 w;
                        w.x = pk2(v0[0] * cc[0] - v0[1] * ss[0], v0[1] * cc[0] + v0[0] * ss[0]);
                        w.y = pk2(v0[2] * cc[1] - v0[3] * ss[1], v0[3] * cc[1] + v0[2] * ss[1]);
                        w.z = pk2(v1[0] * cc[2] - v1[1] * ss[2], v1[1] * cc[2] + v1[0] * ss[2]);
                        w.w = pk2(v1[2] * cc[3] - v1[3] * ss[3], v1[3] * cc[3] + v1[2] * ss[3]);
                        __builtin_nontemporal_store(w, (u32x4*)(base + (size_t)dr * ld * 2 + voff));
                    }
                    asm volatile("" ::: "memory");
                } else if (op >= 2) {
#pragma unroll
                    for (int ai = 0; ai < 2; ++ai)
#pragma unroll
                        for (int m = 0; m < 4; ++m) {
                            const int dr = ai * HALF + m * 16;
                            f32x4 v0 = acc[ai][bj][m][0], v1 = acc[ai][bj][m][1];
#pragma unroll
                            for (int e = 0; e < 4; ++e) {
                                const float s0 = rcpf_(1.f + ex2(-LOG2E * v0[e])), s1 = rcpf_(1.f + ex2(-LOG2E * v1[e]));
                                v0[e] = op == 2 ? v0[e] * s0 : s0; v1[e] = op == 2 ? v1[e] * s1 : s1;
                            }
                            u32x4 w; w.x = pk2(v0[0], v0[1]); w.y = pk2(v0[2], v0[3]); w.z = pk2(v1[0], v1[1]); w.w = pk2(v1[2], v1[3]);
                            __builtin_nontemporal_store(w, (u32x4*)(base + (size_t)dr * ld * 2 + voff));
                            asm volatile("" ::: "memory");
                        }
                } else {
                    const float sc = op == 1 ? C2 : 1.f;
#pragma unroll
                    for (int ai = 0; ai < 2; ++ai)
#pragma unroll
                        for (int m = 0; m < 4; ++m) {
                            const int dr = ai * HALF + m * 16;
                            const f32x4 v0 = acc[ai][bj][m][0] * sc, v1 = acc[ai][bj][m][1] * sc;
                            u32x4 w; w.x = pk2(v0[0], v0[1]); w.y = pk2(v0[2], v0[3]); w.z = pk2(v1[0], v1[1]); w.w = pk2(v1[2], v1[3]);
                            __builtin_nontemporal_store(w, (u32x4*)(base + (size_t)dr * ld * 2 + voff));
                            asm volatile("" ::: "memory");
                        }
                }
            }
        } else if constexpr (KIND == 3 || KIND == 4) {
            const int tid = (wr * 4 + wc) * 64 + fq * 16 + fr;
            const char* ib = (const char*)(xin + u.pn * BM) + (size_t)u.pm * BM * 4096; char* ob = (char*)(xout + u.pn * BM) + (size_t)u.pm * BM * 4096;
            const unsigned xoff = (unsigned)(rl * 1024 + cl) * 4u;
#define PKADD_INPLACE(A, X) do { f32x2_t lo_ = {(A)[0], (A)[1]}, hi_ = {(A)[2], (A)[3]}; const f32x2_t xl_ = {(X)[0], (X)[1]}, xh_ = {(X)[2], (X)[3]}; \
        asm volatile("v_pk_add_f32 %0, %0, %1" : "+v"(lo_) : "v"(xl_)); asm volatile("v_pk_add_f32 %0, %0, %1" : "+v"(hi_) : "v"(xh_)); (A) = (f32x4){lo_[0], lo_[1], hi_[0], hi_[1]}; } while (0)
            unsigned xo = xoff;
#pragma unroll
            for (int bj = 0; bj < 2; ++bj) {
                f32x4 x0[8], x1[8];
#pragma unroll
                for (int q = 0; q < 8; ++q) { const size_t uo = (size_t)((q >> 2) * HALF + (q & 3) * 16) * 4096 + bj * 512; x0[q] = __builtin_nontemporal_load((const f32x4*)(ib + uo + xo)); x1[q] = __builtin_nontemporal_load((const f32x4*)(ib + uo + xo + 16)); }
#pragma unroll
                for (int q = 0; q < 8; ++q) { PKADD_INPLACE(acc[q >> 2][bj][q & 3][0], x0[q]); PKADD_INPLACE(acc[q >> 2][bj][q & 3][1], x1[q]); }
                asm volatile("" : "+v"(xo));
            }
            LAS float* P = (LAS float*)xl;
            LAS float* Sr = (LAS float*)(xl + 4096);
#pragma unroll
            for (int ai = 0; ai < 2; ++ai)
#pragma unroll
                for (int m = 0; m < 4; ++m) {
                    float sq = 0.f;
#pragma unroll
                    for (int bj = 0; bj < 2; ++bj)
#pragma unroll
                        for (int n = 0; n < 2; ++n) { const f32x4 v = acc[ai][bj][m][n]; sq += (v[0] * v[0] + v[1] * v[1]) + (v[2] * v[2] + v[3] * v[3]); }
                    sq += bperm(sq, (fq * 16 + fr) ^ 16); sq += bperm(sq, (fq * 16 + fr) ^ 32);
                    if (fq == 0) P[(ai * HALF + rl + m * 16) * 4 + wc] = sq;
                }
            asm volatile("s_waitcnt lgkmcnt(0)" ::: "memory"); __builtin_amdgcn_s_barrier(); asm volatile("" ::: "memory");
            if (tid < 256) {
                const f32x4 p4 = *(LAS const f32x4*)(P + tid * 4);
                __hip_atomic_store(slots + ((size_t)(u.pm * BM + tid) * 4 + u.pn), __float_as_uint((p4[0] + p4[1]) + (p4[2] + p4[3])), __ATOMIC_RELAXED, __HIP_MEMORY_SCOPE_AGENT);
            }
            asm volatile("s_waitcnt vmcnt(0)" ::: "memory"); __builtin_amdgcn_s_barrier(); asm volatile("" ::: "memory");
            if (tid == 0) {
                __hip_atomic_fetch_add(cnt + 64 * u.pm, 1u, __ATOMIC_RELAXED, __HIP_MEMORY_SCOPE_AGENT);
                unsigned sp = 0;
                while (__hip_atomic_load(cnt + 64 * u.pm, __ATOMIC_RELAXED, __HIP_MEMORY_SCOPE_AGENT) < 4u) { __builtin_amdgcn_s_sleep(2); if (++sp > (1u << 22)) break; }
                __builtin_amdgcn_fence(__ATOMIC_ACQUIRE, "agent");
            }
            asm volatile("s_waitcnt vmcnt(0) lgkmcnt(0)" ::: "memory"); __builtin_amdgcn_s_barrier(); asm volatile("" ::: "memory");
            if (tid < 256) {
                const unsigned* sl = slots + (size_t)(u.pm * BM + tid) * 4; float ss = 0.f;
#pragma unroll
                for (int t4 = 0; t4 < 4; ++t4) ss += __uint_as_float(__hip_atomic_load(sl + t4, __ATOMIC_RELAXED, __HIP_MEMORY_SCOPE_AGENT));
                Sr[tid] = 1.0f / sqrtf(ss * (1.f / 1024.f) + RMS_EPS);
            }
            asm volatile("s_waitcnt lgkmcnt(0)" ::: "memory"); __builtin_amdgcn_s_barrier(); asm volatile("" ::: "memory");
#pragma unroll
            for (int bj = 0; bj < 2; ++bj) {
                const f32x4 g0 = *(const f32x4*)(gfin + u.pn * BM + bj * HALF + cl), g1 = *(const f32x4*)(gfin + u.pn * BM + bj * HALF + cl + 4);
#pragma unroll
                for (int q = 0; q < 8; ++q) { const size_t uo = (size_t)((q >> 2) * HALF + (q & 3) * 16) * 4096 + bj * 512; const float rs = Sr[(q >> 2) * HALF + rl + (q & 3) * 16];
                    const f32x4 h0 = acc[q >> 2][bj][q & 3][0] * rs * g0, h1 = acc[q >> 2][bj][q & 3][1] * rs * g1;
                    if constexpr (KIND == 3) { __builtin_nontemporal_store(h0, (f32x4*)(ob + uo + xoff)); __builtin_nontemporal_store(h1, (f32x4*)(ob + uo + xoff + 16)); }
                    else { __builtin_nontemporal_store(acc[q >> 2][bj][q & 3][0], (f32x4*)(ob + uo + xoff)); __builtin_nontemporal_store(acc[q >> 2][bj][q & 3][1], (f32x4*)(ob + uo + xoff + 16));
                        u32x4 w; w.x = pk2(h0[0], h0[1]); w.y = pk2(h0[2], h0[3]); w.z = pk2(h1[0], h1[1]); w.w = pk2(h1[2], h1[3]);
                        *(u32x4*)((char*)(Hout + u.pn * BM) + (size_t)u.pm * BM * 2048 + (uo >> 1) + (xoff >> 1)) = w; } }
                asm volatile("" ::: "memory");
            }
            asm volatile("s_waitcnt lgkmcnt(0)" ::: "memory"); __builtin_amdgcn_s_barrier(); asm volatile("" ::: "memory");
        } else if constexpr (KIND == 2) {
            const char* ib = (const char*)(xin + u.pn * BM) + (size_t)u.pm * BM * 4096; char* ob = (char*)(xout + u.pn * BM) + (size_t)u.pm * BM * 4096;
            const unsigned xoff = (unsigned)(rl * 1024 + cl) * 4u;
#pragma unroll
            for (int bj = 0; bj < 2; ++bj) {
                f32x4 x0[8], x1[8];
#pragma unroll
                for (int q = 0; q < 8; ++q) { const size_t uo = (size_t)((q >> 2) * HALF + (q & 3) * 16) * 4096 + bj * 512; x0[q] = *(const f32x4*)(ib + uo + xoff); x1[q] = *(const f32x4*)(ib + uo + xoff + 16); }
                asm volatile("" ::: "memory");
#pragma unroll
                for (int q = 0; q < 8; ++q) { const size_t uo = (size_t)((q >> 2) * HALF + (q & 3) * 16) * 4096 + bj * 512;
                    *(f32x4*)(ob + uo + xoff) = x0[q] + acc[q >> 2][bj][q & 3][0]; *(f32x4*)(ob + uo + xoff + 16) = x1[q] + acc[q >> 2][bj][q & 3][1]; }
                asm volatile("" ::: "memory");
            }
        }
#pragma unroll
        for (int bj = 0; bj < 2; ++bj)
#pragma unroll
            for (int ai = 0; ai < 2; ++ai)
#pragma unroll
                for (int m = 0; m < 4; ++m) { acc[ai][bj][m][0] = (f32x4){0.f, 0.f, 0.f, 0.f}; acc[ai][bj][m][1] = (f32x4){0.f, 0.f, 0.f, 0.f}; }
    }
};

template <int KIND> __device__ __forceinline__ void gemm_phase(LAS unsigned char* lds, const bf16_t* A, const bf16_t* Bt, const Sched& S, const Epi& E) {
    int tid_ = threadIdx.x; asm volatile("" : "+v"(tid_));
    const int tid = tid_, wid = __builtin_amdgcn_readfirstlane(tid >> 6), lane = tid & 63, wr = wid >> 2, wc = wid & 3, fr = lane & 15, fq = lane >> 4;
    unsigned voffA[2], voffB[2];
#pragma unroll
    for (int i = 0; i < 2; ++i) { int R, C; stage_rc(tid * 16 + i * 8192, R, C); const int Rb = (R & ~31) + perm32(R & 31);
        voffA[i] = (unsigned)(R * LD + C) * 2u; voffB[i] = (unsigned)(Rb * LD + C) * 2u; }
    const size_t kstep = (size_t)(BK * 2);
    const size_t hstep = (size_t)HALF * LD * 2;
    const size_t tstep = 2 * hstep;
    const unsigned ldsw = (unsigned)wid * 1024u;
    const int aoff = lds_byte(wr * 64 + fr, fq * 8), boff = lds_byte(wc * 32 + fr, fq * 8);
#define PG8_SA(b, h) (((b) * 2 + (h)) * HTB)
#define PG8_SB(b, h) ((4 + (b) * 2 + (h)) * HTB)
#define PG8_STAGE(bufoff, gbase, voff) do { _Pragma("unroll") for (int _i = 0; _i < 2; ++_i) \
        __builtin_amdgcn_global_load_lds((const unsigned*)((const char*)(gbase) + (voff)[_i]), (LAS unsigned*)(lds + (bufoff) + ldsw + _i * 8192), 16, 0, 0); } while (0)
#define PG8_LDA(dst, b, h) do { _Pragma("unroll") for (int m = 0; m < 4; ++m) _Pragma("unroll") for (int k = 0; k < 2; ++k) dst[m][k] = *(const LAS bf16x8*)(lds + PG8_SA(b, h) + aoff + m * 2048 + k * 1024); } while (0)
#define PG8_LDB(dst, b, h) do { _Pragma("unroll") for (int n = 0; n < 2; ++n) _Pragma("unroll") for (int k = 0; k < 2; ++k) dst[n][k] = *(const LAS bf16x8*)(lds + PG8_SB(b, h) + boff + n * 2048 + k * 1024); } while (0)
#define PG8_MMA(ai, bj, At, Bt_) do { __builtin_amdgcn_s_setprio(1); _Pragma("unroll") for (int m = 0; m < 4; ++m) _Pragma("unroll") for (int n = 0; n < 2; ++n) _Pragma("unroll") for (int k = 0; k < 2; ++k) \
        acc[ai][bj][m][n] = __builtin_amdgcn_mfma_f32_16x16x32_bf16(Bt_[n][k], At[m][k], acc[ai][bj][m][n], 0, 0, 0); __builtin_amdgcn_s_setprio(0); } while (0)
#define PG8_WAIT_V(n) asm volatile("s_waitcnt vmcnt(" #n ")" ::: "memory")
#define PG8_WAIT_L(n) asm volatile("s_waitcnt lgkmcnt(" #n ")" ::: "memory")
#define PG8_BAR __builtin_amdgcn_s_barrier()
#define PG8_SCHED __builtin_amdgcn_sched_barrier(0)
    Unit cur, nxt; int ui = 0;
    if (!S.next(0, cur)) return;
    f32x4 acc[2][2][4][2];
#pragma unroll
    for (int a = 0; a < 2; ++a)
#pragma unroll
        for (int b = 0; b < 2; ++b)
#pragma unroll
            for (int m = 0; m < 4; ++m)
#pragma unroll
                for (int n = 0; n < 2; ++n) acc[a][b][m][n] = (f32x4){0.f, 0.f, 0.f, 0.f};
    bf16x8 At[4][2], B0[2][2], B1[2][2];
    const char* cA = (const char*)A + (size_t)cur.pm * tstep + (size_t)cur.k0 * 2; const char* cB = (const char*)Bt + (size_t)cur.pn * tstep + (size_t)cur.k0 * 2;
    PG8_STAGE(PG8_SB(0, 0), cB, voffB); PG8_STAGE(PG8_SB(0, 1), cB + hstep, voffB); PG8_STAGE(PG8_SA(0, 0), cA, voffA); PG8_STAGE(PG8_SA(0, 1), cA + hstep, voffA);
    if (wr == 1) PG8_BAR;
    PG8_WAIT_V(2); PG8_BAR;
    PG8_STAGE(PG8_SB(1, 0), cB + kstep, voffB); PG8_STAGE(PG8_SA(1, 0), cA + kstep, voffA); PG8_STAGE(PG8_SB(1, 1), cB + hstep + kstep, voffB);
    PG8_WAIT_V(6); PG8_BAR;
    for (;;) {
        const bool has_next = S.next(ui + 1, nxt);
        const char* nA = has_next ? (const char*)A + (size_t)nxt.pm * tstep + (size_t)nxt.k0 * 2 : cA; const char* nB = has_next ? (const char*)Bt + (size_t)nxt.pn * tstep + (size_t)nxt.k0 * 2 : cB;
        const int nt = cur.nt;
        for (int t = 0; t < nt; t += 2) {
            const bool last = (t == nt - 2);
            const char* a1 = cA + (size_t)(t + 1) * kstep;
            const char* a2 = last ? nA : cA + (size_t)(t + 2) * kstep; const char* b2 = last ? nB : cB + (size_t)(t + 2) * kstep;
            const char* a3 = a2 + kstep; const char* b3 = b2 + kstep;
            PG8_LDB(B0, 0, 0); PG8_LDB(B1, 0, 1); PG8_SCHED; PG8_LDA(At, 0, 0); PG8_STAGE(PG8_SA(1, 1), a1 + hstep, voffA);
            PG8_WAIT_V(8); PG8_WAIT_L(0); PG8_BAR; PG8_MMA(0, 0, At, B0); PG8_MMA(0, 1, At, B1); PG8_BAR; PG8_SCHED;
            PG8_LDA(At, 0, 1); PG8_STAGE(PG8_SB(0, 0), b2, voffB); PG8_STAGE(PG8_SB(0, 1), b2 + hstep, voffB); PG8_STAGE(PG8_SA(0, 0), a2, voffA);
            PG8_WAIT_V(8); PG8_WAIT_L(0); PG8_BAR; PG8_MMA(1, 0, At, B0); PG8_MMA(1, 1, At, B1); PG8_BAR; PG8_SCHED;
            PG8_LDB(B0, 1, 0); PG8_LDB(B1, 1, 1); PG8_SCHED; PG8_LDA(At, 1, 0); PG8_STAGE(PG8_SA(0, 1), a2 + hstep, voffA);
            PG8_WAIT_V(8); PG8_WAIT_L(0); PG8_BAR; PG8_MMA(0, 0, At, B0); PG8_MMA(0, 1, At, B1); PG8_BAR; PG8_SCHED;
            PG8_LDA(At, 1, 1); PG8_STAGE(PG8_SB(1, 0), b3, voffB); PG8_STAGE(PG8_SB(1, 1), b3 + hstep, voffB); PG8_STAGE(PG8_SA(1, 0), a3, voffA);
            PG8_WAIT_V(8); PG8_WAIT_L(0); PG8_BAR; PG8_MMA(1, 0, At, B0); PG8_MMA(1, 1, At, B1); PG8_BAR; PG8_SCHED;
        }
        if (wr == 0) PG8_BAR;
        E.template run<KIND>(acc, cur, wr, wc, fr, fq);
        if (!has_next) break;
        cur = nxt; cA = nA; cB = nB; ++ui;
        if (wr == 1) PG8_BAR;
    }
    PG8_WAIT_V(0);
    PG8_BAR;
#undef PG8_SA
#undef PG8_SB
#undef PG8_STAGE
#undef PG8_LDA
#undef PG8_LDB
#undef PG8_MMA
#undef PG8_WAIT_V
#undef PG8_WAIT_L
#undef PG8_BAR
#undef PG8_SCHED
}
}

struct Args {
    const float* x; const float* norm_g; const float* w_in; const float* b_forget; const float* sinks;
    const float* w_br_a; const float* w_br_b; const float* w_br_c; const float* w_out; const float* final_g;
    float* out; unsigned char* ws;
    float inv_freq[32];
};

__device__ __forceinline__ float wave_sum(float v, int lane) {
#pragma unroll
    for (int o = 1; o < 64; o <<= 1) v += bperm(v, lane ^ o);
    return v;
}
__device__ __forceinline__ int orig_col(int np) {
    if (np < 768) return np;
    const bool rope = (np >= 1024 && np < 1792) || (np >= 2560 && np < 3072);
    if (!rope) return np + 4;
    const int p = np & 63, base = np - p;
    return base + (p >> 1) + 32 * (p & 1) + 4;
}
__device__ __forceinline__ void transpose_item(const float* W, int ldw, bool permute, bf16_t* WT, int ldt, int kdst, LAS float* scr, int k0, int n0, int lane) {
    const int nn = n0 + (lane & 31), sc = permute ? orig_col(nn) : nn;
#pragma unroll 8
    for (int i = 0; i < 32; ++i) { const int kk = 2 * i + (lane >> 5); scr[kk * 33 + (lane & 31)] = __builtin_nontemporal_load(W + (size_t)(k0 + kk) * ldw + sc); }
    asm volatile("s_waitcnt lgkmcnt(0)" ::: "memory");
    const int c = lane & 7;
#pragma unroll
    for (int j = 0; j < 4; ++j) { const int n = (lane >> 3) + 8 * j; const LAS float* s = scr + (8 * c) * 33 + n;
        u32x4 o; o.x = pk2(s[0 * 33], s[1 * 33]); o.y = pk2(s[2 * 33], s[3 * 33]); o.z = pk2(s[4 * 33], s[5 * 33]); o.w = pk2(s[6 * 33], s[7 * 33]);
        *(u32x4*)(WT + (size_t)(n0 + n) * ldt + kdst + k0 + 8 * c) = o; }
    asm volatile("s_waitcnt lgkmcnt(0)" ::: "memory");
}

__device__ __forceinline__ void prep_phase(const Args& a, int layer, LAS unsigned char* lds, int vcu, int G) {
    int tid_ = threadIdx.x; asm volatile("" : "+v"(tid_));
    const int tid = tid_, lane = tid & 63, wave = __builtin_amdgcn_readfirstlane(tid >> 6);
    LAS float* scr = (LAS float*)(lds + wave * 16384);
    const int gw = vcu * 8 + wave, NGW = G * 8;
    unsigned char* ws = a.ws;
    const float* w_in = a.w_in + (size_t)layer * D * NIN;
    constexpr int I_IN = 16 * (NP / 32), I_A = 4 * 32, I_B = 6 * 32, I_C = 6 * 32, I_O = 16 * 32;
    constexpr int NITEMS = I_IN + I_A + I_B + I_C + I_O;
    for (int it = gw; it < NITEMS; it += NGW) {
        int r = it;
        if (r < I_IN) { const int nb = r % (NP / 32), kb = r / (NP / 32); transpose_item(w_in, NIN, true, (bf16_t*)(ws + WS_WIN), 1024, 0, scr, 64 * kb, 32 * nb, lane); continue; } r -= I_IN;
        if (r < I_A) { transpose_item(a.w_br_a + (size_t)layer * 256 * 1024, 1024, false, (bf16_t*)(ws + WS_WBR), 1024, 0, scr, 64 * (r / 32), 32 * (r % 32), lane); continue; } r -= I_A;
        if (r < I_B) { transpose_item(a.w_br_b + (size_t)layer * 384 * 1024, 1024, false, (bf16_t*)(ws + WS_WBR), 1024, 256, scr, 64 * (r / 32), 32 * (r % 32), lane); continue; } r -= I_B;
        if (r < I_C) { transpose_item(a.w_br_c + (size_t)layer * 384 * 1024, 1024, false, (bf16_t*)(ws + WS_WBR), 1024, 640, scr, 64 * (r / 32), 32 * (r % 32), lane); continue; } r -= I_C;
        transpose_item(a.w_out + (size_t)layer * 1024 * 1024, 1024, false, (bf16_t*)(ws + WS_WOUT), 1024, 0, scr, 64 * (r / 32), 32 * (r % 32), lane);
    }
    if (layer == 0) {
        float* cosT = (float*)(ws + WS_COS); float* sinT = (float*)(ws + WS_SIN);
        for (int e = vcu * NTHREADS + tid; e < SEQ * 32; e += G * NTHREADS) {
            const int pos = e >> 5, i = e & 31;
            const float angf = (float)pos * a.inv_freq[i];
            const double ang = (double)angf;
            const double n = __builtin_rint(ang * 0.15915494309189535);
            double r = ang - n * 6.283185307179586232; r -= n * 2.449293598294706414e-16;
            const double r2 = r * r;
            double cs = 1.0, sn = 1.0;
            double cc = 0.0, ss = 0.0;
#pragma unroll
            for (int k = 13; k >= 1; --k) { cc = (cc + 1.0) * (-r2 / (double)((2 * k - 1) * (2 * k))); ss = (ss + 1.0) * (-r2 / (double)((2 * k) * (2 * k + 1))); }
            cs = 1.0 + cc; sn = r * (1.0 + ss);
            cosT[e] = (float)cs; sinT[e] = (float)sn;
        }
    }
    const float* xin = layer == 0 ? a.x : a.out;
    const float* g = a.norm_g + layer * D;
    f32x4 gv[4], wf[16];
#pragma unroll
    for (int j = 0; j < 4; ++j) gv[j] = *(const f32x4*)(g + 256 * j + 4 * lane);
#pragma unroll
    for (int j = 0; j < 4; ++j)
#pragma unroll
        for (int e = 0; e < 4; ++e) wf[4 * j + e] = *(const f32x4*)(w_in + (size_t)(256 * j + 4 * lane + e) * NIN + 768);
    const f32x4 bfv = *(const f32x4*)(a.b_forget + 4 * layer);
    bf16_t* H = (bf16_t*)(ws + WS_H); float* logf = (float*)(ws + WS_LOGF);
    if (layer > 0) {
        for (int m = gw; m < M; m += NGW) {
            const u32x2* hr = (const u32x2*)(H + (size_t)m * D) + lane;
            f32x4 fa = (f32x4){0.f, 0.f, 0.f, 0.f};
#pragma unroll
            for (int j = 0; j < 4; ++j) { const u32x2 hw = hr[64 * j];
                fa += wf[4 * j + 0] * bflo(hw.x); fa += wf[4 * j + 1] * bfhi(hw.x); fa += wf[4 * j + 2] * bflo(hw.y); fa += wf[4 * j + 3] * bfhi(hw.y); }
            fa.x = wave_sum(fa.x, lane); fa.y = wave_sum(fa.y, lane); fa.z = wave_sum(fa.z, lane); fa.w = wave_sum(fa.w, lane);
            if (lane == 0) {
                f32x4 o;
#pragma unroll
                for (int e = 0; e < 4; ++e) { const float t = fa[e] + bfv[e]; o[e] = fminf(t, 0.f) - log1pf(expf(-fabsf(t))); }
                *(f32x4*)(logf + (size_t)m * 4) = o;
            }
        }
        return;
    }
    for (int m = gw; m < M; m += NGW) {
        const f32x4* xr = (const f32x4*)(xin + (size_t)m * D) + lane;
        f32x4 v[4]; float s2 = 0.f;
#pragma unroll
        for (int j = 0; j < 4; ++j) { v[j] = __builtin_nontemporal_load(xr + 64 * j); s2 += (v[j].x * v[j].x + v[j].y * v[j].y) + (v[j].z * v[j].z + v[j].w * v[j].w); }
        const float rs = 1.0f / sqrtf(wave_sum(s2, lane) * (1.f / D) + RMS_EPS);
        f32x4 fa = (f32x4){0.f, 0.f, 0.f, 0.f};
        unsigned long long* o8 = (unsigned long long*)(H + (size_t)m * D) + lane;
#pragma unroll
        for (int j = 0; j < 4; ++j) {
            const f32x4 h = v[j] * rs * gv[j];
            fa += wf[4 * j + 0] * h.x; fa += wf[4 * j + 1] * h.y; fa += wf[4 * j + 2] * h.z; fa += wf[4 * j + 3] * h.w;
            o8[64 * j] = (unsigned long long)pk2(h.x, h.y) | ((unsigned long long)pk2(h.z, h.w) << 32);
        }
        fa.x = wave_sum(fa.x, lane); fa.y = wave_sum(fa.y, lane); fa.z = wave_sum(fa.z, lane); fa.w = wave_sum(fa.w, lane);
        if (lane == 0) {
            f32x4 o;
#pragma unroll
            for (int e = 0; e < 4; ++e) { const float t = fa[e] + bfv[e]; o[e] = fminf(t, 0.f) - log1pf(expf(-fabsf(t))); }
            *(f32x4*)(logf + (size_t)m * 4) = o;
        }
    }
}

__device__ __forceinline__ void cumsum_phase(const Args& a, int blk) {
    if (blk >= 8) return;
    int tid_ = threadIdx.x; asm volatile("" : "+v"(tid_));
    const int tid = tid_, lane = tid & 63, w = tid >> 6, seq = blk * 8 + w, b = seq >> 2, h = seq & 3;
    const float* lf = (const float*)(a.ws + WS_LOGF) + ((size_t)b * SEQ + 32 * lane) * 4 + h;
    float* cb = (float*)(a.ws + WS_CB) + (size_t)(b * 4 + h) * SEQ + 32 * lane;
    float v[32]; float run = 0.f;
#pragma unroll
    for (int i = 0; i < 32; ++i) { run += lf[4 * i]; v[i] = run; }
    float x = run;
#pragma unroll
    for (int o = 1; o < 64; o <<= 1) { const float t = bperm(x, lane >= o ? lane - o : lane); if (lane >= o) x += t; }
    const float excl = x - run;
#pragma unroll
    for (int i = 0; i < 32; i += 4) { f32x4 o4; o4.x = -LOG2E * (excl + v[i]); o4.y = -LOG2E * (excl + v[i + 1]); o4.z = -LOG2E * (excl + v[i + 2]); o4.w = -LOG2E * (excl + v[i + 3]); *(f32x4*)(cb + i) = o4; }
}

namespace attn {
constexpr int KPL = 2064;
constexpr int VPL = 8256;
constexpr int OFF_V = 8 * KPL;
constexpr int OFF_B = OFF_V + 2 * VPL;
constexpr int BUF = OFF_B + 512;
constexpr int NBUF = 3;
constexpr int OFF_WS = NBUF * BUF;
constexpr int OFF_ST = OFF_WS + 8 * 256;
constexpr int ST_BYTES = 32 * 144;
static_assert(OFF_ST + 8 * ST_BYTES <= LDS_BYTES - 256, "attention LDS map");

struct Item { int valid, type, b, h, qcol, kcol, vcol, zcol, ycol, dil, res0, M0, c0, c1, W; };

__device__ __forceinline__ Item make_item(int sub, int g, int j) {
    Item it; it.valid = 0; it.type = 0; it.b = 0; it.h = 0; it.qcol = 0; it.kcol = 0; it.vcol = 0; it.zcol = 0; it.ycol = 0; it.dil = 1; it.res0 = 0; it.M0 = 0; it.c0 = 0; it.c1 = 1; it.W = 128;
    if (sub == 0) {
        if (j >= 8) return it;
        it.valid = 1;
        if (j < 2) {
            const int bh = g >> 2, s = g & 3, qb = j == 0 ? s : 7 - s, h = bh & 3;
            it.type = 0; it.b = bh >> 2; it.h = h; it.qcol = 64 * h; it.kcol = 256 + 64 * h; it.vcol = 512 + 64 * h; it.zcol = 768 + 64 * h; it.ycol = 64 * h;
            it.M0 = 256 * qb; it.c0 = 0; it.c1 = 2 * (qb + 1); it.W = 1 << 30; return it;
        }
        const bool isC = j >= 5; const int idx = g * 3 + (j - (isC ? 5 : 2)), b = idx / 48, rem = idx % 48, h = rem >> 3, blk = rem & 7;
        it.b = b; it.h = h; it.M0 = 256 * blk; it.c0 = blk == 0 ? 1 : 0; it.c1 = 3;
        const int kvh = h / 3;
        it.type = isC ? 4 : 1; it.qcol = (isC ? 2560 : 1024) + 64 * h; it.kcol = isC ? 2944 + 64 * kvh : 1408 + 64 * h; it.vcol = isC ? 3072 + 64 * kvh : 1792 + 64 * h;
        it.zcol = (isC ? 3200 : 2176) + 64 * h; it.ycol = (isC ? 640 : 256) + 64 * h; it.W = isC ? 127 : 128;
        return it;
    }
    if (j >= 3) return it;
    it.valid = 1;
    const int idx = g * 3 + j, b = idx / 48, rem = idx % 48, h = rem >> 3, r8 = rem & 7;
    it.b = b; it.h = h; it.qcol = 1024 + 64 * h; it.kcol = 1408 + 64 * h; it.vcol = 1792 + 64 * h; it.zcol = 2176 + 64 * h; it.ycol = 256 + 64 * h; it.W = 128;
    const int blk = r8 & 1;
    it.type = sub == 1 ? 2 : 3; it.dil = sub == 1 ? 4 : 16; it.res0 = sub == 1 ? (r8 >> 1) : 2 * r8; it.M0 = sub == 1 ? 256 * blk : 0; it.c0 = (sub == 1 && blk == 0) ? 1 : 0; it.c1 = sub == 1 ? 3 : 2;
    return it;
}
__device__ __forceinline__ void chunk_src(const Item& it, int c, int& kp0, int& kres) {
    if (it.type == 0) { kp0 = 128 * c; kres = 0; }
    else if (it.type == 3) { kp0 = 0; kres = it.res0 + c; }
    else { kp0 = it.M0 - 128 + 128 * c; kres = it.res0; }
}
__device__ __forceinline__ s16x4 vtr(LAS const unsigned char* p) {
    typedef short v4i16_t __attribute__((ext_vector_type(4)));
    return __builtin_bit_cast(s16x4, __builtin_amdgcn_ds_read_tr16_b64_v4i16((LAS v4i16_t*)p));
}

__device__ __forceinline__ void attn_phase(const Args& a, int layer, int sub, LAS unsigned char* lds, int g) {
    int tid_ = threadIdx.x; asm volatile("" : "+v"(tid_));
    const int tid = tid_, lane = tid & 63, w = __builtin_amdgcn_readfirstlane(tid >> 6), hi = lane >> 5, l31 = lane & 31;
    const bf16_t* QKVZ = (const bf16_t*)(a.ws + WS_QKVZ); bf16_t* Y = (bf16_t*)(a.ws + WS_H); float* LSE = (float*)(a.ws + WS_LSE); const float* CB = (const float*)(a.ws + WS_CB);
    LAS float* wsf = (LAS float*)(lds + OFF_WS + w * 256);
    LAS bf16_t* stg = (LAS bf16_t*)(lds + OFF_ST + w * ST_BYTES);
    int j = 0, cb;
    { const Item it0 = make_item(sub, g, 0); if (!it0.valid) return; cb = it0.c0; }
    u32x4 kreg[NBUF][2], vreg[NBUF][2]; float breg[NBUF]; bf16x8 qn[4];
#define ATT_ISSUE(IT, CBEG, NCH) do { _Pragma("unroll") for (int ci_ = 0; ci_ < NBUF; ++ci_) if (ci_ < (NCH)) { int kp0_, kres_; chunk_src(IT, (CBEG) + ci_, kp0_, kres_); \
        _Pragma("unroll") for (int i_ = 0; i_ < 2; ++i_) { const int p_ = tid + 512 * i_, key_ = p_ >> 3, c16_ = p_ & 7; int m_ = kp0_ + key_; m_ = m_ < 0 ? 0 : m_; \
            const bf16_t* rp_ = QKVZ + (size_t)((IT).b * SEQ + m_ * (IT).dil + kres_) * NQ + c16_ * 8; \
            kreg[ci_][i_] = *(const u32x4*)(rp_ + (IT).kcol); vreg[ci_][i_] = *(const u32x4*)(rp_ + (IT).vcol); } \
        breg[ci_] = CB[(size_t)((IT).b * 4 + ((IT).h & 3)) * SEQ + ((kp0_ + (tid & 127)) & (SEQ - 1))]; } \
        if ((CBEG) == (IT).c0) { const int qres_ = (IT).type == 3 ? (IT).res0 + (w >> 2) : (IT).res0, mq0_ = (IT).type == 3 ? 32 * (w & 3) : (IT).M0 + 32 * w; \
            const bf16_t* qp_ = QKVZ + (size_t)((IT).b * SEQ + (mq0_ + l31) * (IT).dil + qres_) * NQ + (IT).qcol + 8 * hi; \
            _Pragma("unroll") for (int s_ = 0; s_ < 4; ++s_) qn[s_] = __builtin_nontemporal_load((const bf16x8*)(qp_ + 16 * s_)); } } while (0)
    { const Item it0 = make_item(sub, g, 0); const int n0 = it0.c1 - cb < NBUF ? it0.c1 - cb : NBUF; ATT_ISSUE(it0, cb, n0); }
    bf16x8 qf[4]; f32x16 o0, o1; float mrun = -1e30f, lrun = 0.f;
    for (;;) {
        const Item it = make_item(sub, g, j);
        const int nch = it.c1 - cb < NBUF ? it.c1 - cb : NBUF;
        int ncb = cb + nch, nj = j;
        if (ncb >= it.c1) nj = j + 1;
        const Item nx = make_item(sub, g, nj);
        const bool has_next = nx.valid != 0;
        if (nj != j) ncb = nx.c0;
        const int nnch = nx.c1 - ncb < NBUF ? nx.c1 - ncb : NBUF;
        __syncthreads();
#pragma unroll
        for (int ci = 0; ci < NBUF; ++ci) if (ci < nch) {
            LAS unsigned char* wb = lds + ci * BUF;
#pragma unroll
            for (int i = 0; i < 2; ++i) { const int p = tid + 512 * i, key = p >> 3, c16 = p & 7;
                *(LAS u32x4*)(wb + c16 * KPL + key * 16) = kreg[ci][i];
                *(LAS u32x4*)(wb + OFF_V + (c16 >> 2) * VPL + (key >> 3) * 512 + (key & 7) * 64 + (c16 & 3) * 16) = vreg[ci][i]; }
            if (tid < 128) *(LAS float*)(wb + OFF_B + tid * 4) = breg[ci];
        }
        __syncthreads();
        const int qres = it.type == 3 ? it.res0 + (w >> 2) : it.res0;
        const int mq0 = it.type == 3 ? 32 * (w & 3) : it.M0 + 32 * w;
        if (cb == it.c0) {
#pragma unroll
            for (int s = 0; s < 4; ++s) qf[s] = qn[s];
        }
        if (has_next) ATT_ISSUE(nx, ncb, nnch);
        if (cb == it.c0) {
#pragma unroll
            for (int r = 0; r < 16; ++r) { o0[r] = 0.f; o1[r] = 0.f; }
            mrun = -1e30f; lrun = 0.f;
        }
#pragma unroll 1
        for (int ci = 0; ci < nch; ++ci) {
        const int c = cb + ci;
        LAS unsigned char* buf = lds + ci * BUF;
        int kp0, kres; chunk_src(it, c, kp0, kres);
        if (kres == qres) {
#pragma unroll 1
            for (int jp = 0; jp < 2; ++jp) {
                const int a0 = kp0 + 64 * jp;
                if (a0 > mq0 + 31 || a0 + 63 < mq0 - it.W || a0 + 63 < 0) continue;
                const bool needmask = !(a0 + 63 <= mq0 && a0 >= mq0 + 31 - it.W && a0 >= 0);
                LAS const unsigned char* kb = buf + hi * KPL + (64 * jp + l31) * 16;
                const bf16x8 kf0 = *(LAS const bf16x8*)(kb), kf1 = *(LAS const bf16x8*)(kb + 2 * KPL), kf2 = *(LAS const bf16x8*)(kb + 4 * KPL), kf3 = *(LAS const bf16x8*)(kb + 6 * KPL);
                const bf16x8 kg0 = *(LAS const bf16x8*)(kb + 512), kg1 = *(LAS const bf16x8*)(kb + 512 + 2 * KPL), kg2 = *(LAS const bf16x8*)(kb + 512 + 4 * KPL), kg3 = *(LAS const bf16x8*)(kb + 512 + 6 * KPL);
                f32x16 s, t;
                if (it.type == 0) {
#pragma unroll
                    for (int g4 = 0; g4 < 4; ++g4) { const f32x4 bv = *(LAS const f32x4*)(buf + OFF_B + (64 * jp + 8 * g4 + 4 * hi) * 4), bw = *(LAS const f32x4*)(buf + OFF_B + (64 * jp + 32 + 8 * g4 + 4 * hi) * 4);
                        s[4 * g4] = bv.x; s[4 * g4 + 1] = bv.y; s[4 * g4 + 2] = bv.z; s[4 * g4 + 3] = bv.w; t[4 * g4] = bw.x; t[4 * g4 + 1] = bw.y; t[4 * g4 + 2] = bw.z; t[4 * g4 + 3] = bw.w; }
                    s = __builtin_amdgcn_mfma_f32_32x32x16_bf16(kf0, qf[0], s, 0, 0, 0);
                    t = __builtin_amdgcn_mfma_f32_32x32x16_bf16(kg0, qf[0], t, 0, 0, 0);
                } else {
                    const f32x16 z16 = {0.f, 0.f, 0.f, 0.f, 0.f, 0.f, 0.f, 0.f, 0.f, 0.f, 0.f, 0.f, 0.f, 0.f, 0.f, 0.f};
                    s = __builtin_amdgcn_mfma_f32_32x32x16_bf16(kf0, qf[0], z16, 0, 0, 0);
                    t = __builtin_amdgcn_mfma_f32_32x32x16_bf16(kg0, qf[0], z16, 0, 0, 0);
                }
                s = __builtin_amdgcn_mfma_f32_32x32x16_bf16(kf1, qf[1], s, 0, 0, 0);
                t = __builtin_amdgcn_mfma_f32_32x32x16_bf16(kg1, qf[1], t, 0, 0, 0);
                s = __builtin_amdgcn_mfma_f32_32x32x16_bf16(kf2, qf[2], s, 0, 0, 0);
                t = __builtin_amdgcn_mfma_f32_32x32x16_bf16(kg2, qf[2], t, 0, 0, 0);
                s = __builtin_amdgcn_mfma_f32_32x32x16_bf16(kf3, qf[3], s, 0, 0, 0);
                t = __builtin_amdgcn_mfma_f32_32x32x16_bf16(kg3, qf[3], t, 0, 0, 0);
                LAS const unsigned char* vb = buf + OFF_V + (8 * jp) * 512 + (4 * hi + ((lane & 15) >> 2)) * 64 + ((lane >> 4) & 1) * 32 + (lane & 3) * 8;
#define ATT_VF(cc, ks) ({ const s16x4 lo_ = vtr(vb + (cc) * VPL + (2 * (ks)) * 512), hi_ = vtr(vb + (cc) * VPL + (2 * (ks) + 1) * 512); (bf16x8){lo_[0], lo_[1], lo_[2], lo_[3], hi_[0], hi_[1], hi_[2], hi_[3]}; })
                const bf16x8 v00 = ATT_VF(0, 0), v01 = ATT_VF(0, 1), v02 = ATT_VF(0, 2), v03 = ATT_VF(0, 3), v10 = ATT_VF(1, 0), v11 = ATT_VF(1, 1), v12 = ATT_VF(1, 2), v13 = ATT_VF(1, 3);
#undef ATT_VF
                if (needmask) {
                    const int qpos = mq0 + l31;
#pragma unroll
                    for (int r = 0; r < 16; ++r) { const int kpos = a0 + (r & 3) + 8 * (r >> 2) + 4 * hi; const bool ok = kpos >= 0 && kpos <= qpos && qpos - kpos <= it.W; s[r] = ok ? s[r] : -INFINITY;
                        const int kp2 = kpos + 32; const bool ok2 = kp2 >= 0 && kp2 <= qpos && qpos - kp2 <= it.W; t[r] = ok2 ? t[r] : -INFINITY; }
                }
                float mx = __builtin_fmaxf(__builtin_fmaxf(s[0], s[1]), t[0]), my = __builtin_fmaxf(__builtin_fmaxf(s[2], s[3]), t[1]);
                mx = __builtin_fmaxf(__builtin_fmaxf(mx, t[2]), t[3]);
#pragma unroll
                for (int r = 4; r < 16; r += 4) { mx = __builtin_fmaxf(__builtin_fmaxf(mx, s[r]), s[r + 1]); my = __builtin_fmaxf(__builtin_fmaxf(my, s[r + 2]), s[r + 3]); mx = __builtin_fmaxf(__builtin_fmaxf(mx, t[r]), t[r + 1]); my = __builtin_fmaxf(__builtin_fmaxf(my, t[r + 2]), t[r + 3]); }
                mx = __builtin_fmaxf(mx, my);
                { const auto rr = __builtin_amdgcn_permlane32_swap(__float_as_uint(mx), __float_as_uint(mx), false, false); mx = fmaxf(__uint_as_float(rr[0]), __uint_as_float(rr[1])); }
                const float mnew = fmaxf(mrun, mx);
                if (__any(mx > mrun + 16.0f)) {
                    const float alpha = ex2(mrun - mnew); lrun *= alpha; mrun = mnew;
                    if (hi == 0) wsf[l31] = alpha;
#pragma unroll
                    for (int g4 = 0; g4 < 4; ++g4) { const f32x4 av = *(LAS const f32x4*)(wsf + 8 * g4 + 4 * hi);
                        o0[4 * g4] *= av.x; o0[4 * g4 + 1] *= av.y; o0[4 * g4 + 2] *= av.z; o0[4 * g4 + 3] *= av.w;
                        o1[4 * g4] *= av.x; o1[4 * g4 + 1] *= av.y; o1[4 * g4 + 2] *= av.z; o1[4 * g4 + 3] *= av.w; }
                }
                float ps = 0.f, pt = 0.f;
#pragma unroll
                for (int r = 0; r < 16; ++r) { s[r] = ex2(s[r] - mrun); ps += s[r]; t[r] = ex2(t[r] - mrun); pt += t[r]; }
                lrun += ps + pt;
                u32x4 pw0, pw1, pw2, pw3;
                pw0.x = pk2(s[0], s[1]); pw0.y = pk2(s[2], s[3]); pw0.z = pk2(s[4], s[5]); pw0.w = pk2(s[6], s[7]);
                pw1.x = pk2(s[8], s[9]); pw1.y = pk2(s[10], s[11]); pw1.z = pk2(s[12], s[13]); pw1.w = pk2(s[14], s[15]);
                pw2.x = pk2(t[0], t[1]); pw2.y = pk2(t[2], t[3]); pw2.z = pk2(t[4], t[5]); pw2.w = pk2(t[6], t[7]);
                pw3.x = pk2(t[8], t[9]); pw3.y = pk2(t[10], t[11]); pw3.z = pk2(t[12], t[13]); pw3.w = pk2(t[14], t[15]);
                const bf16x8 pa0 = __builtin_bit_cast(bf16x8, pw0), pa1 = __builtin_bit_cast(bf16x8, pw1), pa2 = __builtin_bit_cast(bf16x8, pw2), pa3 = __builtin_bit_cast(bf16x8, pw3);
                o0 = __builtin_amdgcn_mfma_f32_32x32x16_bf16(pa0, v00, o0, 0, 0, 0);
                o1 = __builtin_amdgcn_mfma_f32_32x32x16_bf16(pa0, v10, o1, 0, 0, 0);
                o0 = __builtin_amdgcn_mfma_f32_32x32x16_bf16(pa1, v01, o0, 0, 0, 0);
                o1 = __builtin_amdgcn_mfma_f32_32x32x16_bf16(pa1, v11, o1, 0, 0, 0);
                o0 = __builtin_amdgcn_mfma_f32_32x32x16_bf16(pa2, v02, o0, 0, 0, 0);
                o1 = __builtin_amdgcn_mfma_f32_32x32x16_bf16(pa2, v12, o1, 0, 0, 0);
                o0 = __builtin_amdgcn_mfma_f32_32x32x16_bf16(pa3, v03, o0, 0, 0, 0);
                o1 = __builtin_amdgcn_mfma_f32_32x32x16_bf16(pa3, v13, o1, 0, 0, 0);
            }
        }
        }
        if (cb + nch == it.c1) {
            float lt; { const auto rr = __builtin_amdgcn_permlane32_swap(__float_as_uint(lrun), __float_as_uint(lrun), false, false); lt = __uint_as_float(rr[0]) + __uint_as_float(rr[1]); }
            float scale, L2 = 0.f;
            if (it.type == 4) { const float sink2 = a.sinks[layer * 6 + it.h] * LOG2E, mf = fmaxf(mrun, sink2), al = ex2(mrun - mf); scale = al / (lt * al + ex2(sink2 - mf)); }
            else { scale = 1.f / lt; L2 = mrun + log2f(lt); }
            if (hi == 0) { wsf[l31] = scale; wsf[32 + l31] = L2; }
#pragma unroll
            for (int g4 = 0; g4 < 4; ++g4) { const f32x4 av = *(LAS const f32x4*)(wsf + 8 * g4 + 4 * hi);
#pragma unroll
                for (int e = 0; e < 4; ++e) { const int r = 4 * g4 + e, row = 8 * g4 + 4 * hi + e;
                    stg[row * 72 + l31] = (bf16_t)f2bf(o0[r] * av[e]); stg[row * 72 + 32 + l31] = (bf16_t)f2bf(o1[r] * av[e]); } }
#pragma unroll
            for (int i = 0; i < 4; ++i) {
                const int row = i * 8 + (lane >> 3), ch = lane & 7;
                const u32x4 ov = *(LAS const u32x4*)(stg + row * 72 + ch * 8);
                const size_t tok = (size_t)(it.b * SEQ + (mq0 + row) * it.dil + qres);
                bf16_t* yp = Y + tok * 1024 + it.ycol + ch * 8;
                float f[8] = {bflo(ov.x), bfhi(ov.x), bflo(ov.y), bfhi(ov.y), bflo(ov.z), bfhi(ov.z), bflo(ov.w), bfhi(ov.w)};
                if (it.type == 1) { if (ch == 0) LSE[tok * 6 + it.h] = wsf[32 + row]; }
                if (it.type == 2 || it.type == 3) {
                    const u32x4 od = *(const u32x4*)yp; const float Lold = LSE[tok * 6 + it.h], Lnew = wsf[32 + row], Lm = fmaxf(Lold, Lnew);
                    float wo = ex2(Lold - Lm), wn = ex2(Lnew - Lm); const float sw = wo + wn, inv = 1.f / sw; wo *= inv; wn *= inv;
                    const float q[8] = {bflo(od.x), bfhi(od.x), bflo(od.y), bfhi(od.y), bflo(od.z), bfhi(od.z), bflo(od.w), bfhi(od.w)};
#pragma unroll
                    for (int e = 0; e < 8; ++e) f[e] = wo * q[e] + wn * f[e];
                    if (it.type == 2 && ch == 0) LSE[tok * 6 + it.h] = Lm + log2f(sw);
                }
                if (it.type == 0 || it.type >= 3) {
                    const u32x4 zv = __builtin_nontemporal_load((const u32x4*)(QKVZ + tok * NQ + it.zcol + ch * 8));
                    const float z[8] = {bflo(zv.x), bfhi(zv.x), bflo(zv.y), bfhi(zv.y), bflo(zv.z), bfhi(zv.z), bflo(zv.w), bfhi(zv.w)};
#pragma unroll
                    for (int e = 0; e < 8; ++e) f[e] *= z[e];
                }
                u32x4 wv; wv.x = pk2(f[0], f[1]); wv.y = pk2(f[2], f[3]); wv.z = pk2(f[4], f[5]); wv.w = pk2(f[6], f[7]);
                *(u32x4*)yp = wv;
            }
        }
        if (!has_next) break;
        cb = ncb; j = nj;
    }
#undef ATT_ISSUE
}
}

__device__ __forceinline__ void final_norm_phase(const Args& a, int vcu, int G) {
    int tid_ = threadIdx.x; asm volatile("" : "+v"(tid_));
    const int tid = tid_, lane = tid & 63, wave = tid >> 6, gw = vcu * 8 + wave, NGW = G * 8;
    f32x4 gv[4];
#pragma unroll
    for (int j = 0; j < 4; ++j) gv[j] = *(const f32x4*)(a.final_g + 256 * j + 4 * lane);
    for (int m = gw; m < M; m += NGW) {
        f32x4* xr = (f32x4*)(a.out + (size_t)m * D) + lane;
        f32x4 v[4]; float s2 = 0.f;
#pragma unroll
        for (int j = 0; j < 4; ++j) { v[j] = xr[64 * j]; s2 += (v[j].x * v[j].x + v[j].y * v[j].y) + (v[j].z * v[j].z + v[j].w * v[j].w); }
        const float rs = 1.0f / sqrtf(wave_sum(s2, lane) * (1.f / D) + RMS_EPS);
#pragma unroll
        for (int j = 0; j < 4; ++j) xr[64 * j] = v[j] * rs * gv[j];
    }
}


#define XB_TMO      128
#define XB_XCNT(j)  (256  + 64 * (j))
#define XB_XSUB(j)  (1280 + 64 * (j))
#define XB_XGEN(j)  (2304 + 64 * (j))
#define XB_TOP      3328
#define XB_TOPGEN   3392
#define XCD_BAR_WORDS 3456
#define XB_SPIN_CAP (1u << 18)
__device__ __forceinline__ unsigned xb_ld(unsigned* p)              { return __hip_atomic_load(p, __ATOMIC_RELAXED, __HIP_MEMORY_SCOPE_AGENT); }
__device__ __forceinline__ unsigned xb_add(unsigned* p, unsigned v) { return __hip_atomic_fetch_add(p, v, __ATOMIC_RELAXED, __HIP_MEMORY_SCOPE_AGENT); }
__device__ __forceinline__ unsigned xb_xcc_id() { return (unsigned)__builtin_amdgcn_s_getreg((3 << 11) | 20) & 0xFu; }
#define XB_SPIN(cond, bar) do { unsigned _sp = 0; while (cond) { __builtin_amdgcn_s_sleep(1); \
    if ((++_sp & 255u) == 0u) { if (xb_ld(&(bar)[XB_TMO])) break; if (_sp > XB_SPIN_CAP) { atomicAdd(&(bar)[XB_TMO], 1u); break; } } } } while (0)
struct XcdBarrier { unsigned* bar; unsigned x; volatile LAS unsigned* st; };
__device__ __forceinline__ XcdBarrier xcd_barrier_post(unsigned* bar, volatile LAS unsigned* st) {
    XcdBarrier b; b.bar = bar; b.x = xb_xcc_id(); b.st = st;
    if (threadIdx.x == 0) (void)xb_add(&bar[XB_XCNT(b.x)], 1u);
    return b;
}
__device__ __forceinline__ void xcd_barrier_complete(unsigned* bar, unsigned x, unsigned& nloc, unsigned& nx) {
    const unsigned G = gridDim.x * gridDim.y * gridDim.z;
    unsigned sum, cnt, mine, sp = 0u;
    for (;;) {
        sum = 0u; cnt = 0u; mine = 0u;
#pragma unroll
        for (unsigned j = 0; j < 16; ++j) { const unsigned c = xb_ld(&bar[XB_XCNT(j)]); sum += c; cnt += (c > 0u) ? 1u : 0u; mine = (j == x) ? c : mine; }
        if (sum == G) break;
        __builtin_amdgcn_s_sleep(1);
        if ((++sp & 255u) == 0u) { if (xb_ld(&bar[XB_TMO])) break; if (sp > XB_SPIN_CAP) { atomicAdd(&bar[XB_TMO], 1u); break; } }
    }
    nloc = mine > 0u ? mine : 1u; nx = cnt > 0u ? cnt : 1u;
}
__device__ __forceinline__ void xcd_barrier(const XcdBarrier& b) {
    asm volatile("s_waitcnt vmcnt(0)" ::: "memory");
    __syncthreads();
    if (threadIdx.x == 0) {
        unsigned* bar = b.bar;
        __builtin_amdgcn_s_waitcnt(0);
        unsigned nloc = b.st[0], nx = b.st[1];
        if (nloc == 0u) { xcd_barrier_complete(bar, b.x, nloc, nx); b.st[0] = nloc; b.st[1] = nx; }
        const unsigned old = xb_add(&bar[XB_XSUB(b.x)], 1u);
        const unsigned gen = old / nloc;
        if (old + 1u == (gen + 1u) * nloc) {
            __builtin_amdgcn_fence(__ATOMIC_RELEASE, "agent");
            asm volatile("s_waitcnt vmcnt(0)" ::: "memory");
            const unsigned og = xb_add(&bar[XB_TOP], 1u);
            const unsigned tg = og / nx;
            if (og + 1u == (tg + 1u) * nx) xb_add(&bar[XB_TOPGEN], 1u);
            else XB_SPIN(xb_ld(&bar[XB_TOPGEN]) == tg, bar);
            __builtin_amdgcn_fence(__ATOMIC_ACQUIRE, "agent");
            xb_add(&bar[XB_XGEN(b.x)], 1u);
            asm volatile("s_waitcnt vmcnt(0)" ::: "memory");
        } else {
            XB_SPIN(xb_ld(&bar[XB_XGEN(b.x)]) == gen, bar);
            __builtin_amdgcn_fence(__ATOMIC_ACQUIRE, "agent");
            asm volatile("s_waitcnt vmcnt(0)" ::: "memory");
        }
    }
    __syncthreads();
}

__global__ void __launch_bounds__(NTHREADS, 2) fwd_megakernel(Args a) {
    extern __shared__ __attribute__((aligned(16))) unsigned char lds_raw[];
    cg::grid_group grid = cg::this_grid();
    LAS unsigned char* lds = (LAS unsigned char*)lds_raw;
    const int G = gridDim.x, bx = blockIdx.x;
    const int vcu = (G % 8 == 0) ? (bx % 8) * (G / 8) + bx / 8 : bx;
    unsigned char* ws = a.ws;
    if (ws == nullptr) grid.sync();
    volatile LAS unsigned* bst = (volatile LAS unsigned*)(lds + LDS_BYTES - 64);
    if (threadIdx.x < 2) bst[threadIdx.x] = 0u;
    __syncthreads();
    const XcdBarrier bar = xcd_barrier_post((unsigned*)ws, bst);
#pragma unroll 1
    for (int step = 0; step < 14; ++step) {
        const int layer = step / 7, ph = step - 7 * layer;
#ifndef NO_PREP
        if (ph == 0) { for (int rep = 0; rep < PROBE_REP_PREP; ++rep) prep_phase(a, layer, lds, vcu, G); }
        else
#endif
        if (ph == 1 || ph >= 5) {
#ifndef NO_GEMM
            if (ph == 1) cumsum_phase(a, bx);
            pg8::Sched S; S.kind = ph == 1 ? 0 : (ph == 5 ? 1 : 2); S.so.init(M, ph == 1 ? NP : 1024, G, bx, ph == 1 ? GEMM1_WGM : 8);
            pg8::Epi E; E.QKVZ = (bf16_t*)(ws + WS_QKVZ); E.Gt = (bf16_t*)(ws + WS_G); E.MERGED = (bf16_t*)(ws + WS_QKVZ);
            E.xin = layer == 0 ? a.x : a.out; E.xout = a.out; E.cosT = (const float*)(ws + WS_COS); E.sinT = (const float*)(ws + WS_SIN);
            E.gfin = layer == 0 ? a.norm_g + D : a.final_g; E.Hout = (bf16_t*)(ws + WS_H); E.slots = (unsigned*)(ws + WS_SLOTS); E.cnt = (unsigned*)(ws + 16384 + layer * 32768); E.xl = lds + 131072;
            const bf16_t* A = ph == 1 ? (const bf16_t*)(ws + WS_H) : (ph == 5 ? (const bf16_t*)(ws + WS_H) : (const bf16_t*)(ws + WS_QKVZ));
            const bf16_t* Bt = ph == 1 ? (const bf16_t*)(ws + WS_WIN) : (ph == 5 ? (const bf16_t*)(ws + WS_WBR) : (const bf16_t*)(ws + WS_WOUT));
#ifdef ONLY_KIND
            pg8::gemm_phase<ONLY_KIND>(lds, A, Bt, S, E);
#else
            if (ph == 1) { for (int rep = 0; rep < PROBE_REP_GEMM1; ++rep) pg8::gemm_phase<0>(lds, A, Bt, S, E); } else if (ph == 5) { for (int rep = 0; rep < PROBE_REP_MERGE; ++rep) pg8::gemm_phase<1>(lds, A, Bt, S, E); } else if (layer == 0) pg8::gemm_phase<4>(lds, A, Bt, S, E); else pg8::gemm_phase<3>(lds, A, Bt, S, E);
#endif
#endif
        }
#ifndef NO_ATTN
        else { const int nrep = ph == 2 ? PROBE_REP_ATT0 : 1; for (int rep = 0; rep < nrep; ++rep) { attn::attn_phase(a, layer, ph - 2, lds, vcu); __syncthreads(); } }
#endif
        if (step == 13) break;
        xcd_barrier(bar);
#ifdef PROBE_SYNC2
        xcd_barrier(bar);
#endif
    }
}

extern "C" void kernel_launch(void* const* d_in, const int* in_sizes, int n_in, void* d_out, int out_size, void* d_ws, size_t ws_size, hipStream_t stream) {
    static int grid = 0;
    if (grid == 0) {
        if (n_in != 10 || in_sizes[0] != M * D || out_size != M * D || ws_size < WS_END) { fprintf(stderr, "kernel_launch: unexpected shapes/workspace (n_in %d, in0 %d, out %d, ws %zu)\n", n_in, n_in > 0 ? in_sizes[0] : -1, out_size, ws_size); grid = -1; return; }
        int dev = 0, cus = 0, per_cu = 0;
        if (hipGetDevice(&dev) != hipSuccess || hipDeviceGetAttribute(&cus, hipDeviceAttributeMultiprocessorCount, dev) != hipSuccess) { grid = -1; return; }
        if (hipFuncSetAttribute((const void*)fwd_megakernel, hipFuncAttributeMaxDynamicSharedMemorySize, LDS_BYTES) != hipSuccess) { fprintf(stderr, "kernel_launch: hipFuncSetAttribute failed\n"); grid = -1; return; }
        if (hipOccupancyMaxActiveBlocksPerMultiprocessor(&per_cu, (const void*)fwd_megakernel, NTHREADS, LDS_BYTES) != hipSuccess || per_cu < 1) { fprintf(stderr, "kernel_launch: occupancy query gave %d\n", per_cu); (void)hipGetLastError(); per_cu = 1; }
        grid = cus * (per_cu > 1 ? 1 : per_cu);
    }
    if (grid < 0) return;
    if (hipMemsetAsync(d_ws, 0, 131072, stream) != hipSuccess) { fprintf(stderr, "kernel_launch: memset of barrier words failed\n"); return; }
    Args a{};
    a.x = (const float*)d_in[0]; a.norm_g = (const float*)d_in[1]; a.w_in = (const float*)d_in[2]; a.b_forget = (const float*)d_in[3]; a.sinks = (const float*)d_in[4];
    a.w_br_a = (const float*)d_in[5]; a.w_br_b = (const float*)d_in[6]; a.w_br_c = (const float*)d_in[7]; a.w_out = (const float*)d_in[8]; a.final_g = (const float*)d_in[9];
    a.out = (float*)d_out; a.ws = (unsigned char*)d_ws;
    for (int i = 0; i < 32; ++i) a.inv_freq[i] = powf(10000.0f, -(float)(2 * i) / 64.0f);
    void* args[] = {&a};
    hipError_t e = hipLaunchCooperativeKernel((const void*)fwd_megakernel, dim3(grid), dim3(NTHREADS), args, LDS_BYTES, stream);
    if (e != hipSuccess) fprintf(stderr, "kernel_launch: cooperative launch failed: %s (grid %d)\n", hipGetErrorString(e), grid);
}
```

```cpp
#include <hip/hip_runtime.h>
#include <hip/hip_cooperative_groups.h>
#include <cstdio>
#include <cstdint>
#include <cmath>
namespace cg = cooperative_groups;

#define LAS __attribute__((address_space(3)))
#define GAS __attribute__((address_space(1)))
typedef unsigned short bf16_t;
typedef short bf16x8 __attribute__((ext_vector_type(8)));
typedef short s16x4 __attribute__((ext_vector_type(4)));
typedef float f32x4 __attribute__((ext_vector_type(4)));
typedef float f32x16 __attribute__((ext_vector_type(16)));
typedef unsigned u32x4 __attribute__((ext_vector_type(4)));
typedef unsigned u32x2 __attribute__((ext_vector_type(2)));

constexpr int SEQ = 2048, NBATCH = 16, M = NBATCH * SEQ, D = 1024;
constexpr int NIN = 6660;
constexpr int NP = 6656;
constexpr int NQ = 3584;
constexpr int NGC = 3072;
constexpr float LOG2E = 1.4426950408889634f;
constexpr float C2 = 0.125f * LOG2E;
constexpr float RMS_EPS = 1e-6f;

constexpr size_t MiB = 1u << 20;
constexpr size_t WS_COS = 1 * MiB;
constexpr size_t WS_SIN = WS_COS + 256 * 1024;
constexpr size_t WS_LOGF = WS_SIN + 256 * 1024;
constexpr size_t WS_CB = WS_LOGF + 512 * 1024;
constexpr size_t WS_LSE = WS_CB + 512 * 1024;
constexpr size_t WS_SLOTS = 512 * 1024;
constexpr size_t WS_WIN = 4 * MiB;
constexpr size_t WS_WBR = 17 * MiB;
constexpr size_t WS_WOUT = 19 * MiB;
constexpr size_t WS_H = 22 * MiB;
constexpr size_t WS_QKVZ = 86 * MiB;
constexpr size_t WS_G = 310 * MiB;
constexpr size_t WS_END = 502 * MiB;

constexpr int LDS_BYTES = 147456;
constexpr int NTHREADS = 512;
#ifndef PROBE_REP_GEMM1
#define PROBE_REP_GEMM1 1
#endif
#ifndef PROBE_REP_MERGE
#define PROBE_REP_MERGE 1
#endif
#ifndef PROBE_REP_PREP
#define PROBE_REP_PREP 1
#endif
#ifndef PROBE_REP_ATT0
#define PROBE_REP_ATT0 1
#endif

__device__ __forceinline__ unsigned f2bf(float f) { unsigned u = __builtin_bit_cast(unsigned, f); return (u + 0x7fffu + ((u >> 16) & 1u)) >> 16; }
typedef float f32x2_t __attribute__((ext_vector_type(2))); typedef __bf16 bf16x2_t __attribute__((ext_vector_type(2)));
__device__ __forceinline__ unsigned pk2(float lo, float hi) { f32x2_t v = {lo, hi}; bf16x2_t b = __builtin_convertvector(v, bf16x2_t); return __builtin_bit_cast(unsigned, b); }
__device__ __forceinline__ float bflo(unsigned w) { return __builtin_bit_cast(float, w << 16); }
__device__ __forceinline__ float bfhi(unsigned w) { return __builtin_bit_cast(float, w & 0xffff0000u); }
__device__ __forceinline__ float ex2(float x) { return __builtin_amdgcn_exp2f(x); }
__device__ __forceinline__ float rcpf_(float x) { return __builtin_amdgcn_rcpf(x); }
__device__ __forceinline__ float bperm(float v, int src_lane) { return __builtin_bit_cast(float, __builtin_amdgcn_ds_bpermute(src_lane << 2, __builtin_bit_cast(int, v))); }

namespace pg8 {
constexpr int BM = 256, BK = 64, HALF = 128, HTB = HALF * BK * 2, STAGE_BYTES = 8 * HTB, NXCD = 8, WGM = 8, LD = 1024;
__device__ __forceinline__ int lds_byte(int r, int c) { const int st = (r >> 4) * 2 + (c >> 5), rr = r & 15, cc = c & 31, ob = rr * 64 + cc * 2; return st * 1024 + (ob ^ (((ob >> 9) & 1) << 5)); }
__device__ __forceinline__ void stage_rc(int b, int& R, int& C) { const int st = b / 1024, sb = b % 1024, swz = sb ^ (((sb >> 9) & 1) << 5); R = (st >> 1) * 16 + swz / 64; C = (st & 1) * 32 + (swz % 64) / 2; }
__device__ __forceinline__ int perm32(int rho) { const int n = rho >> 4, i = rho & 15; return 8 * (i >> 2) + 4 * n + (i & 3); }

struct Unit { int pm, pn, k0, nt, mode; };

struct StaticOrder {
    int nM, nN, nwg, G, c;
    __device__ void init(int M_, int N_, int G_, int c_) { nM = M_ / BM; nN = N_ / BM; nwg = nM * nN; G = G_; c = c_; }
    __device__ bool next(int i, Unit& u) const {
        const long L = (long)i * G + c; if (L >= nwg) return false;
        int wgid = (int)L; { const int q = nwg / NXCD, r = nwg % NXCD, xcd = wgid % NXCD, off = wgid / NXCD; wgid = (xcd < r ? xcd * (q + 1) : r * (q + 1) + (xcd - r) * q) + off; }
        const int nig = WGM * nN, gid = wgid / nig, fm = gid * WGM, gsz = (nM - fm) < WGM ? (nM - fm) : WGM;
        u.pm = fm + ((wgid % nig) % gsz); u.pn = (wgid % nig) / gsz; return true;
    }
};
struct Sched {
    StaticOrder so; int kind;
    __device__ bool next(int i, Unit& u) const {
        if (kind == 1) { const int t = i / 3, br = i - 3 * t; if (!so.next(t, u)) return false; u.k0 = br == 0 ? 0 : (br == 1 ? 256 : 640); u.nt = br == 0 ? 4 : 6; u.mode = 1 + br; return true; }
        if (!so.next(i, u)) return false; u.k0 = 0; u.nt = 16; u.mode = kind == 0 ? 0 : 4; return true;
    }
};

struct Epi {
    bf16_t* QKVZ; bf16_t* Gt; bf16_t* MERGED; const float* xin; float* xout; const float* cosT; const float* sinT;
    const float* gfin; bf16_t* Hout; unsigned* slots; unsigned* cnt; LAS unsigned char* xl;
    __device__ __forceinline__ static int blockop(int blk) {
        if (blk >= 28) return 3;
        if (blk < 8) return blk < 2 ? 1 : (blk < 6 ? 0 : 2);
        if (blk < 20) { const int t = blk - 8; return t < 3 ? 5 : (t < 6 ? 4 : (t < 9 ? 0 : 2)); }
        const int t = blk - 20; return t < 3 ? 5 : (t == 3 ? 4 : (t == 4 ? 0 : 2));
    }
    template <int KIND> __device__ __forceinline__ void run(f32x4 (&acc)[2][2][4][2], const Unit& u, int wr, int wc, int fr, int fq) const {
        const int rl = wr * 64 + fr, cl = wc * 32 + 8 * fq;
        if constexpr (KIND == 1) {
            const int br = u.mode - 1;
            const char* gbase = (const char*)(Gt + br * 1024 + u.pn * BM) + (size_t)u.pm * BM * NGC * 2;
            unsigned goff = (unsigned)(rl * NGC + cl) * 2u;
            const int gnext = br < 2 ? 2048 : 0;
            const bool rt = br < 2;
#pragma unroll
            for (int bj = 0; bj < 2; ++bj)
#pragma unroll
                for (int ai = 0; ai < 2; ++ai) {
                    u32x4 ga[4], gb[4];
#pragma unroll
                    for (int m = 0; m < 4; ++m) { const char* gp = gbase + (size_t)(ai * HALF + m * 16) * NGC * 2 + bj * 256 + goff; ga[m] = *(const u32x4*)gp; gb[m] = *(const u32x4*)(gp + gnext); }
#pragma unroll
                    for (int m = 0; m < 4; ++m) {
                        f32x4 f0, f1;
                        f0[0] = bflo(ga[m].x) * (rt ? rcpf_(bflo(gb[m].x)) : 1.f); f0[1] = bfhi(ga[m].x) * (rt ? rcpf_(bfhi(gb[m].x)) : 1.f); f0[2] = bflo(ga[m].y) * (rt ? rcpf_(bflo(gb[m].y)) : 1.f); f0[3] = bfhi(ga[m].y) * (rt ? rcpf_(bfhi(gb[m].y)) : 1.f);
                        f1[0] = bflo(ga[m].z) * (rt ? rcpf_(bflo(gb[m].z)) : 1.f); f1[1] = bfhi(ga[m].z) * (rt ? rcpf_(bfhi(gb[m].z)) : 1.f); f1[2] = bflo(ga[m].w) * (rt ? rcpf_(bflo(gb[m].w)) : 1.f); f1[3] = bfhi(ga[m].w) * (rt ? rcpf_(bfhi(gb[m].w)) : 1.f);
#define PKMUL_INPLACE(A, F) do { f32x2_t lo_ = {(A)[0], (A)[1]}, hi_ = {(A)[2], (A)[3]}; const f32x2_t fl_ = {(F)[0], (F)[1]}, fh_ = {(F)[2], (F)[3]}; \
        asm volatile("v_pk_mul_f32 %0, %0, %1" : "+v"(lo_) : "v"(fl_)); asm volatile("v_pk_mul_f32 %0, %0, %1" : "+v"(hi_) : "v"(fh_)); (A) = (f32x4){lo_[0], lo_[1], hi_[0], hi_[1]}; } while (0)
                        PKMUL_INPLACE(acc[ai][bj][m][0], f0); PKMUL_INPLACE(acc[ai][bj][m][1], f1);
                    }
                    asm volatile("" : "+v"(goff));
                }
            if (br == 2) {
                char* mbase = (char*)(MERGED + u.pn * BM) + (size_t)u.pm * BM * 1024 * 2;
                const unsigned moff = (unsigned)(rl * 1024 + cl) * 2u;
#pragma unroll
                for (int bj = 0; bj < 2; ++bj)
#pragma unroll
                    for (int ai = 0; ai < 2; ++ai)
#pragma unroll
                        for (int m = 0; m < 4; ++m) {
                            const f32x4 v0 = acc[ai][bj][m][0], v1 = acc[ai][bj][m][1];
                            u32x4 w; w.x = pk2(v0[0], v0[1]); w.y = pk2(v0[2], v0[3]); w.z = pk2(v1[0], v1[1]); w.w = pk2(v1[2], v1[3]);
                            *(u32x4*)(mbase + (size_t)(ai * HALF + m * 16) * 2048 + bj * 256 + moff) = w;
                        }
            }
            const float keep = br == 2 ? 0.f : 1.f;
#pragma unroll
            for (int bj = 0; bj < 2; ++bj)
#pragma unroll
                for (int ai = 0; ai < 2; ++ai)
#pragma unroll
                    for (int m = 0; m < 4; ++m) { const f32x4 k4 = (f32x4){keep, keep, keep, keep}; PKMUL_INPLACE(acc[ai][bj][m][0], k4); PKMUL_INPLACE(acc[ai][bj][m][1], k4); }
            return;
        }
        if constexpr (KIND == 0) {
            const unsigned toff = (unsigned)(rl * 32 + 16 * (wc & 1) + 4 * fq) * 4u;
            const char* cbase = (const char*)cosT + (size_t)((u.pm & 7) * 256) * 128; const char* sbase = (const char*)sinT + (size_t)((u.pm & 7) * 256) * 128;
#pragma unroll
            for (int bj = 0; bj < 2; ++bj) {
                const int blk = 2 * u.pn + bj, op = blockop(blk);
                const int ld = blk < 28 ? NQ : NGC;
                char* base = (char*)(blk < 28 ? QKVZ + blk * 128 : Gt + (blk - 28) * 128) + (size_t)u.pm * BM * ld * 2;
                const unsigned voff = (unsigned)(rl * ld + cl) * 2u;
                if (op >= 4) {
                    const float sc = op == 5 ? C2 : 1.f;
                    f32x4 c4[8], s4[8];
#pragma unroll
                    for (int q = 0; q < 8; ++q) { const int dr = (q >> 2) * HALF + (q & 3) * 16; c4[q] = *(const f32x4*)(cbase + dr * 128 + toff); s4[q] = *(const f32x4*)(sbase + dr * 128 + toff); }
                    asm volatile("" ::: "memory");
#pragma unroll
                    for (int q = 0; q < 8; ++q) {
                        const int ai = q >> 2, m = q & 3, dr = ai * HALF + m * 16;
                        const f32x4 v0 = acc[ai][bj][m][0], v1 = acc[ai][bj][m][1];
                        const f32x4 cc = c4[q] * sc, ss = s4[q] * sc;
                        u32x4 w;
                        w.x = pk2(v0[0] * cc[0] - v0[1] * ss[0], v0[1] * cc[0] + v0[0] * ss[0]);
                        w.y = pk2(v0[2] * cc[1] - v0[3] * ss[1], v0[3] * cc[1] + v0[2] * ss[1]);
                        w.z = pk2(v1[0] * cc[2] - v1[1] * ss[2], v1[1] * cc[2] + v1[0] * ss[2]);
                        w.w = pk2(v1[2] * cc[3] - v1[3] * ss[3], v1[3] * cc[3] + v1[2] * ss[3]);
                        __builtin_nontemporal_store(w, (u32x4*)(base + (size_t)dr * ld * 2 + voff));
                    }
                    asm volatile("" ::: "memory");
                } else if (op >= 2) {
#pragma unroll
                    for (int ai = 0; ai < 2; ++ai)
#pragma unroll
                        for (int m = 0; m < 4; ++m) {
                            const int dr = ai * HALF + m * 16;
                            f32x4 v0 = acc[ai][bj][m][0], v1 = acc[ai][bj][m][1];
#pragma unroll
                            for (int e = 0; e < 4; ++e) {
                                const float s0 = rcpf_(1.f + ex2(-LOG2E * v0[e])), s1 = rcpf_(1.f + ex2(-LOG2E * v1[e]));
                                v0[e] = op == 2 ? v0[e] * s0 : s0; v1[e] = op == 2 ? v1[e] * s1 : s1;
                            }
                            u32x4 w; w.x = pk2(v0[0], v0[1]); w.y = pk2(v0[2], v0[3]); w.z = pk2(v1[0], v1[1]); w.w = pk2(v1[2], v1[3]);
                            __builtin_nontemporal_store(w, (u32x4*)(base + (size_t)dr * ld * 2 + voff));
                            asm volatile("" ::: "memory");
                        }
                } else {
                    const float sc = op == 1 ? C2 : 1.f;
#pragma unroll
                    for (int ai = 0; ai < 2; ++ai)
#pragma unroll
                        for (int m = 0; m < 4; ++m) {
                            const int dr = ai * HALF + m * 16;
                            const f32x4 v0 = acc[ai][bj][m][0] * sc, v1 = acc[ai][bj][m][1] * sc;
                            u32x4 w; w.x = pk2(v0[0], v0[1]); w.y = pk2(v0[2], v0[3]); w.z = pk2(v1[0], v1[1]); w.w = pk2(v1[2], v1[3]);
                            __builtin_nontemporal_store(w, (u32x4*)(base + (size_t)dr * ld * 2 + voff));
                            asm volatile("" ::: "memory");
                        }
                }
            }
        } else if constexpr (KIND == 3 || KIND == 4) {
            const int tid = (wr * 4 + wc) * 64 + fq * 16 + fr;
            const char* ib = (const char*)(xin + u.pn * BM) + (size_t)u.pm * BM * 4096; char* ob = (char*)(xout + u.pn * BM) + (size_t)u.pm * BM * 4096;
            const unsigned xoff = (unsigned)(rl * 1024 + cl) * 4u;
#define PKADD_INPLACE(A, X) do { f32x2_t lo_ = {(A)[0], (A)[1]}, hi_ = {(A)[2], (A)[3]}; const f32x2_t xl_ = {(X)[0], (X)[1]}, xh_ = {(X)[2], (X)[3]}; \
        asm volatile("v_pk_add_f32 %0, %0, %1" : "+v"(lo_) : "v"(xl_)); asm volatile("v_pk_add_f32 %0, %0, %1" : "+v"(hi_) : "v"(xh_)); (A) = (f32x4){lo_[0], lo_[1], hi_[0], hi_[1]}; } while (0)
            unsigned xo = xoff;
#pragma unroll
            for (int bj = 0; bj < 2; ++bj) {
                f32x4 x0[8], x1[8];
#pragma unroll
                for (int q = 0; q < 8; ++q) { const size_t uo = (size_t)((q >> 2) * HALF + (q & 3) * 16) * 4096 + bj * 512; x0[q] = __builtin_nontemporal_load((const f32x4*)(ib + uo + xo)); x1[q] = __builtin_nontemporal_load((const f32x4*)(ib + uo + xo + 16)); }
#pragma unroll
                for (int q = 0; q < 8; ++q) { PKADD_INPLACE(acc[q >> 2][bj][q & 3][0], x0[q]); PKADD_INPLACE(acc[q >> 2][bj][q & 3][1], x1[q]); }
                asm volatile("" : "+v"(xo));
            }
            LAS float* P = (LAS float*)xl;
            LAS float* Sr = (LAS float*)(xl + 4096);
#pragma unroll
            for (int ai = 0; ai < 2; ++ai)
#pragma unroll
                for (int m = 0; m < 4; ++m) {
                    float sq = 0.f;
#pragma unroll
                    for (int bj = 0; bj < 2; ++bj)
#pragma unroll
                        for (int n = 0; n < 2; ++n) { const f32x4 v = acc[ai][bj][m][n]; sq += (v[0] * v[0] + v[1] * v[1]) + (v[2] * v[2] + v[3] * v[3]); }
                    sq += bperm(sq, (fq * 16 + fr) ^ 16); sq += bperm(sq, (fq * 16 + fr) ^ 32);
                    if (fq == 0) P[(ai * HALF + rl + m * 16) * 4 + wc] = sq;
                }
            asm volatile("s_waitcnt lgkmcnt(0)" ::: "memory"); __builtin_amdgcn_s_barrier(); asm volatile("" ::: "memory");
            if (tid < 256) {
                const f32x4 p4 = *(LAS const f32x4*)(P + tid * 4);
                __hip_atomic_store(slots + ((size_t)(u.pm * BM + tid) * 4 + u.pn), __float_as_uint((p4[0] + p4[1]) + (p4[2] + p4[3])), __ATOMIC_RELAXED, __HIP_MEMORY_SCOPE_AGENT);
            }
            asm volatile("s_waitcnt vmcnt(0)" ::: "memory"); __builtin_amdgcn_s_barrier(); asm volatile("" ::: "memory");
            if (tid == 0) {
                __hip_atomic_fetch_add(cnt + 64 * u.pm, 1u, __ATOMIC_RELAXED, __HIP_MEMORY_SCOPE_AGENT);
                unsigned sp = 0;
                while (__hip_atomic_load(cnt + 64 * u.pm, __ATOMIC_RELAXED, __HIP_MEMORY_SCOPE_AGENT) < 4u) { __builtin_amdgcn_s_sleep(2); if (++sp > (1u << 17)) break; }
                __builtin_amdgcn_fence(__ATOMIC_ACQUIRE, "agent");
            }
            asm volatile("s_waitcnt vmcnt(0) lgkmcnt(0)" ::: "memory"); __builtin_amdgcn_s_barrier(); asm volatile("" ::: "memory");
            if (tid < 256) {
                const unsigned* sl = slots + (size_t)(u.pm * BM + tid) * 4; float ss = 0.f;
#pragma unroll
                for (int t4 = 0; t4 < 4; ++t4) ss += __uint_as_float(__hip_atomic_load(sl + t4, __ATOMIC_RELAXED, __HIP_MEMORY_SCOPE_AGENT));
                Sr[tid] = 1.0f / sqrtf(ss * (1.f / 1024.f) + RMS_EPS);
            }
            asm volatile("s_waitcnt lgkmcnt(0)" ::: "memory"); __builtin_amdgcn_s_barrier(); asm volatile("" ::: "memory");
#pragma unroll
            for (int bj = 0; bj < 2; ++bj) {
                const f32x4 g0 = *(const f32x4*)(gfin + u.pn * BM + bj * HALF + cl), g1 = *(const f32x4*)(gfin + u.pn * BM + bj * HALF + cl + 4);
#pragma unroll
                for (int q = 0; q < 8; ++q) { const size_t uo = (size_t)((q >> 2) * HALF + (q & 3) * 16) * 4096 + bj * 512; const float rs = Sr[(q >> 2) * HALF + rl + (q & 3) * 16];
                    const f32x4 h0 = acc[q >> 2][bj][q & 3][0] * rs * g0, h1 = acc[q >> 2][bj][q & 3][1] * rs * g1;
                    if constexpr (KIND == 3) { __builtin_nontemporal_store(h0, (f32x4*)(ob + uo + xoff)); __builtin_nontemporal_store(h1, (f32x4*)(ob + uo + xoff + 16)); }
                    else { __builtin_nontemporal_store(acc[q >> 2][bj][q & 3][0], (f32x4*)(ob + uo + xoff)); __builtin_nontemporal_store(acc[q >> 2][bj][q & 3][1], (f32x4*)(ob + uo + xoff + 16));
                        u32x4 w; w.x = pk2(h0[0], h0[1]); w.y = pk2(h0[2], h0[3]); w.z = pk2(h1[0], h1[1]); w.w = pk2(h1[2], h1[3]);
                        *(u32x4*)((char*)(Hout + u.pn * BM) + (size_t)u.pm * BM * 2048 + (uo >> 1) + (xoff >> 1)) = w; } }
                asm volatile("" ::: "memory");
            }
            asm volatile("s_waitcnt lgkmcnt(0)" ::: "memory"); __builtin_amdgcn_s_barrier(); asm volatile("" ::: "memory");
        } else if constexpr (KIND == 2) {
            const char* ib = (const char*)(xin + u.pn * BM) + (size_t)u.pm * BM * 4096; char* ob = (char*)(xout + u.pn * BM) + (size_t)u.pm * BM * 4096;
            const unsigned xoff = (unsigned)(rl * 1024 + cl) * 4u;
#pragma unroll
            for (int bj = 0; bj < 2; ++bj) {
                f32x4 x0[8], x1[8];
#pragma unroll
                for (int q = 0; q < 8; ++q) { const size_t uo = (size_t)((q >> 2) * HALF + (q & 3) * 16) * 4096 + bj * 512; x0[q] = *(const f32x4*)(ib + uo + xoff); x1[q] = *(const f32x4*)(ib + uo + xoff + 16); }
                asm volatile("" ::: "memory");
#pragma unroll
                for (int q = 0; q < 8; ++q) { const size_t uo = (size_t)((q >> 2) * HALF + (q & 3) * 16) * 4096 + bj * 512;
                    *(f32x4*)(ob + uo + xoff) = x0[q] + acc[q >> 2][bj][q & 3][0]; *(f32x4*)(ob + uo + xoff + 16) = x1[q] + acc[q >> 2][bj][q & 3][1]; }
                asm volatile("" ::: "memory");
            }
        }
#pragma unroll
        for (int bj = 0; bj < 2; ++bj)
#pragma unroll
            for (int ai = 0; ai < 2; ++ai)
#pragma unroll
                for (int m = 0; m < 4; ++m) { acc[ai][bj][m][0] = (f32x4){0.f, 0.f, 0.f, 0.f}; acc[ai][bj][m][1] = (f32x4){0.f, 0.f, 0.f, 0.f}; }
    }
};

template <int KIND> __device__ __forceinline__ void gemm_phase(LAS unsigned char* lds, const bf16_t* A, const bf16_t* Bt, const Sched& S, const Epi& E) {
    int tid_ = threadIdx.x; asm volatile("" : "+v"(tid_));
    const int tid = tid_, wid = __builtin_amdgcn_readfirstlane(tid >> 6), lane = tid & 63, wr = wid >> 2, wc = wid & 3, fr = lane & 15, fq = lane >> 4;
    unsigned voffA[2], voffB[2];
#pragma unroll
    for (int i = 0; i < 2; ++i) { int R, C; stage_rc(tid * 16 + i * 8192, R, C); const int Rb = (R & ~31) + perm32(R & 31);
        voffA[i] = (unsigned)(R * LD + C) * 2u; voffB[i] = (unsigned)(Rb * LD + C) * 2u; }
    const size_t kstep = (size_t)(BK * 2);
    const size_t hstep = (size_t)HALF * LD * 2;
    const size_t tstep = 2 * hstep;
    const unsigned ldsw = (unsigned)wid * 1024u;
    const int aoff = lds_byte(wr * 64 + fr, fq * 8), boff = lds_byte(wc * 32 + fr, fq * 8);
#define PG8_SA(b, h) (((b) * 2 + (h)) * HTB)
#define PG8_SB(b, h) ((4 + (b) * 2 + (h)) * HTB)
#define PG8_STAGE(bufoff, gbase, voff) do { _Pragma("unroll") for (int _i = 0; _i < 2; ++_i) \
        __builtin_amdgcn_global_load_lds((const unsigned*)((const char*)(gbase) + (voff)[_i]), (LAS unsigned*)(lds + (bufoff) + ldsw + _i * 8192), 16, 0, 0); } while (0)
#define PG8_LDA(dst, b, h) do { _Pragma("unroll") for (int m = 0; m < 4; ++m) _Pragma("unroll") for (int k = 0; k < 2; ++k) dst[m][k] = *(const LAS bf16x8*)(lds + PG8_SA(b, h) + aoff + m * 2048 + k * 1024); } while (0)
#define PG8_LDB(dst, b, h) do { _Pragma("unroll") for (int n = 0; n < 2; ++n) _Pragma("unroll") for (int k = 0; k < 2; ++k) dst[n][k] = *(const LAS bf16x8*)(lds + PG8_SB(b, h) + boff + n * 2048 + k * 1024); } while (0)
#define PG8_MMA(ai, bj, At, Bt_) do { __builtin_amdgcn_s_setprio(1); _Pragma("unroll") for (int m = 0; m < 4; ++m) _Pragma("unroll") for (int n = 0; n < 2; ++n) _Pragma("unroll") for (int k = 0; k < 2; ++k) \
        acc[ai][bj][m][n] = __builtin_amdgcn_mfma_f32_16x16x32_bf16(Bt_[n][k], At[m][k], acc[ai][bj][m][n], 0, 0, 0); __builtin_amdgcn_s_setprio(0); } while (0)
#define PG8_WAIT_V(n) asm volatile("s_waitcnt vmcnt(" #n ")" ::: "memory")
#define PG8_WAIT_L(n) asm volatile("s_waitcnt lgkmcnt(" #n ")" ::: "memory")
#define PG8_BAR __builtin_amdgcn_s_barrier()
#define PG8_SCHED __builtin_amdgcn_sched_barrier(0)
    Unit cur, nxt; int ui = 0;
    if (!S.next(0, cur)) return;
    f32x4 acc[2][2][4][2];
#pragma unroll
    for (int a = 0; a < 2; ++a)
#pragma unroll
        for (int b = 0; b < 2; ++b)
#pragma unroll
            for (int m = 0; m < 4; ++m)
#pragma unroll
                for (int n = 0; n < 2; ++n) acc[a][b][m][n] = (f32x4){0.f, 0.f, 0.f, 0.f};
    bf16x8 At[4][2], B0[2][2], B1[2][2];
    const char* cA = (const char*)A + (size_t)cur.pm * tstep + (size_t)cur.k0 * 2; const char* cB = (const char*)Bt + (size_t)cur.pn * tstep + (size_t)cur.k0 * 2;
    PG8_STAGE(PG8_SB(0, 0), cB, voffB); PG8_STAGE(PG8_SB(0, 1), cB + hstep, voffB); PG8_STAGE(PG8_SA(0, 0), cA, voffA); PG8_STAGE(PG8_SA(0, 1), cA + hstep, voffA);
    if (wr == 1) PG8_BAR;
    PG8_WAIT_V(2); PG8_BAR;
    PG8_STAGE(PG8_SB(1, 0), cB + kstep, voffB); PG8_STAGE(PG8_SA(1, 0), cA + kstep, voffA); PG8_STAGE(PG8_SB(1, 1), cB + hstep + kstep, voffB);
    PG8_WAIT_V(6); PG8_BAR;
    for (;;) {
        const bool has_next = S.next(ui + 1, nxt);
        const char* nA = has_next ? (const char*)A + (size_t)nxt.pm * tstep + (size_t)nxt.k0 * 2 : cA; const char* nB = has_next ? (const char*)Bt + (size_t)nxt.pn * tstep + (size_t)nxt.k0 * 2 : cB;
        const int nt = cur.nt;
        for (int t = 0; t < nt; t += 2) {
            const bool last = (t == nt - 2);
            const char* a1 = cA + (size_t)(t + 1) * kstep;
            const char* a2 = last ? nA : cA + (size_t)(t + 2) * kstep; const char* b2 = last ? nB : cB + (size_t)(t + 2) * kstep;
            const char* a3 = a2 + kstep; const char* b3 = b2 + kstep;
            PG8_LDB(B0, 0, 0); PG8_LDB(B1, 0, 1); PG8_SCHED; PG8_LDA(At, 0, 0); PG8_STAGE(PG8_SA(1, 1), a1 + hstep, voffA);
            PG8_WAIT_V(8); PG8_WAIT_L(0); PG8_BAR; PG8_MMA(0, 0, At, B0); PG8_MMA(0, 1, At, B1); PG8_BAR; PG8_SCHED;
            PG8_LDA(At, 0, 1); PG8_STAGE(PG8_SB(0, 0), b2, voffB); PG8_STAGE(PG8_SB(0, 1), b2 + hstep, voffB); PG8_STAGE(PG8_SA(0, 0), a2, voffA);
            PG8_WAIT_V(8); PG8_WAIT_L(0); PG8_BAR; PG8_MMA(1, 0, At, B0); PG8_MMA(1, 1, At, B1); PG8_BAR; PG8_SCHED;
            PG8_LDB(B0, 1, 0); PG8_LDB(B1, 1, 1); PG8_SCHED; PG8_LDA(At, 1, 0); PG8_STAGE(PG8_SA(0, 1), a2 + hstep, voffA);
            PG8_WAIT_V(8); PG8_WAIT_L(0); PG8_BAR; PG8_MMA(0, 0, At, B0); PG8_MMA(0, 1, At, B1); PG8_BAR; PG8_SCHED;
            PG8_LDA(At, 1, 1); PG8_STAGE(PG8_SB(1, 0), b3, voffB); PG8_STAGE(PG8_SB(1, 1), b3 + hstep, voffB); PG8_STAGE(PG8_SA(1, 0), a3, voffA);
            PG8_WAIT_V(8); PG8_WAIT_L(0); PG8_BAR; PG8_MMA(1, 0, At, B0); PG8_MMA(1, 1, At, B1); PG8_BAR; PG8_SCHED;
        }
        if (wr == 0) PG8_BAR;
        E.template run<KIND>(acc, cur, wr, wc, fr, fq);
        if (!has_next) break;
        cur = nxt; cA = nA; cB = nB; ++ui;
        if (wr == 1) PG8_BAR;
    }
    PG8_WAIT_V(0);
    PG8_BAR;
#undef PG8_SA
#undef PG8_SB
#undef PG8_STAGE
#undef PG8_LDA
#undef PG8_LDB
#undef PG8_MMA
#undef PG8_WAIT_V
#undef PG8_WAIT_L
#undef PG8_BAR
#undef PG8_SCHED
}
}

struct Args {
    const float* x; const float* norm_g; const float* w_in; const float* b_forget; const float* sinks;
    const float* w_br_a; const float* w_br_b; const float* w_br_c; const float* w_out; const float* final_g;
    float* out; unsigned char* ws;
    float inv_freq[32];
};

__device__ __forceinline__ float wave_sum(float v, int lane) {
#pragma unroll
    for (int o = 1; o < 64; o <<= 1) v += bperm(v, lane ^ o);
    return v;
}
__device__ __forceinline__ int orig_col(int np) {
    if (np < 768) return np;
    const bool rope = (np >= 1024 && np < 1792) || (np >= 2560 && np < 3072);
    if (!rope) return np + 4;
    const int p = np & 63, base = np - p;
    return base + (p >> 1) + 32 * (p & 1) + 4;
}
__device__ __forceinline__ void transpose_item(const float* W, int ldw, bool permute, bf16_t* WT, int ldt, int kdst, LAS float* scr, int k0, int n0, int lane) {
    const int nn = n0 + (lane & 31), sc = permute ? orig_col(nn) : nn;
#pragma unroll 8
    for (int i = 0; i < 32; ++i) { const int kk = 2 * i + (lane >> 5); scr[kk * 33 + (lane & 31)] = __builtin_nontemporal_load(W + (size_t)(k0 + kk) * ldw + sc); }
    asm volatile("s_waitcnt lgkmcnt(0)" ::: "memory");
    const int c = lane & 7;
#pragma unroll
    for (int j = 0; j < 4; ++j) { const int n = (lane >> 3) + 8 * j; const LAS float* s = scr + (8 * c) * 33 + n;
        u32x4 o; o.x = pk2(s[0 * 33], s[1 * 33]); o.y = pk2(s[2 * 33], s[3 * 33]); o.z = pk2(s[4 * 33], s[5 * 33]); o.w = pk2(s[6 * 33], s[7 * 33]);
        *(u32x4*)(WT + (size_t)(n0 + n) * ldt + kdst + k0 + 8 * c) = o; }
    asm volatile("s_waitcnt lgkmcnt(0)" ::: "memory");
}

__device__ __forceinline__ void prep_phase(const Args& a, int layer, LAS unsigned char* lds, int vcu, int G) {
    int tid_ = threadIdx.x; asm volatile("" : "+v"(tid_));
    const int tid = tid_, lane = tid & 63, wave = __builtin_amdgcn_readfirstlane(tid >> 6);
    LAS float* scr = (LAS float*)(lds + wave * 16384);
    const int gw = vcu * 8 + wave, NGW = G * 8;
    unsigned char* ws = a.ws;
    const float* w_in = a.w_in + (size_t)layer * D * NIN;
    constexpr int I_IN = 16 * (NP / 32), I_A = 4 * 32, I_B = 6 * 32, I_C = 6 * 32, I_O = 16 * 32;
    constexpr int NITEMS = I_IN + I_A + I_B + I_C + I_O;
    for (int it = gw; it < NITEMS; it += NGW) {
        int r = it;
        if (r < I_IN) { const int nb = r % (NP / 32), kb = r / (NP / 32); transpose_item(w_in, NIN, true, (bf16_t*)(ws + WS_WIN), 1024, 0, scr, 64 * kb, 32 * nb, lane); continue; } r -= I_IN;
        if (r < I_A) { transpose_item(a.w_br_a + (size_t)layer * 256 * 1024, 1024, false, (bf16_t*)(ws + WS_WBR), 1024, 0, scr, 64 * (r / 32), 32 * (r % 32), lane); continue; } r -= I_A;
        if (r < I_B) { transpose_item(a.w_br_b + (size_t)layer * 384 * 1024, 1024, false, (bf16_t*)(ws + WS_WBR), 1024, 256, scr, 64 * (r / 32), 32 * (r % 32), lane); continue; } r -= I_B;
        if (r < I_C) { transpose_item(a.w_br_c + (size_t)layer * 384 * 1024, 1024, false, (bf16_t*)(ws + WS_WBR), 1024, 640, scr, 64 * (r / 32), 32 * (r % 32), lane); continue; } r -= I_C;
        transpose_item(a.w_out + (size_t)layer * 1024 * 1024, 1024, false, (bf16_t*)(ws + WS_WOUT), 1024, 0, scr, 64 * (r / 32), 32 * (r % 32), lane);
    }
    if (layer == 0) {
        float* cosT = (float*)(ws + WS_COS); float* sinT = (float*)(ws + WS_SIN);
        for (int e = vcu * NTHREADS + tid; e < SEQ * 32; e += G * NTHREADS) {
            const int pos = e >> 5, i = e & 31;
            const float angf = (float)pos * a.inv_freq[i];
            const double ang = (double)angf;
            const double n = __builtin_rint(ang * 0.15915494309189535);
            double r = ang - n * 6.283185307179586232; r -= n * 2.449293598294706414e-16;
            const double r2 = r * r;
            double cs = 1.0, sn = 1.0;
            double cc = 0.0, ss = 0.0;
#pragma unroll
            for (int k = 13; k >= 1; --k) { cc = (cc + 1.0) * (-r2 / (double)((2 * k - 1) * (2 * k))); ss = (ss + 1.0) * (-r2 / (double)((2 * k) * (2 * k + 1))); }
            cs = 1.0 + cc; sn = r * (1.0 + ss);
            cosT[e] = (float)cs; sinT[e] = (float)sn;
        }
    }
    const float* xin = layer == 0 ? a.x : a.out;
    const float* g = a.norm_g + layer * D;
    f32x4 gv[4], wf[16];
#pragma unroll
    for (int j = 0; j < 4; ++j) gv[j] = *(const f32x4*)(g + 256 * j + 4 * lane);
#pragma unroll
    for (int j = 0; j < 4; ++j)
#pragma unroll
        for (int e = 0; e < 4; ++e) wf[4 * j + e] = *(const f32x4*)(w_in + (size_t)(256 * j + 4 * lane + e) * NIN + 768);
    const f32x4 bfv = *(const f32x4*)(a.b_forget + 4 * layer);
    bf16_t* H = (bf16_t*)(ws + WS_H); float* logf = (float*)(ws + WS_LOGF);
    if (layer > 0) {
        for (int m = gw; m < M; m += NGW) {
            const u32x2* hr = (const u32x2*)(H + (size_t)m * D) + lane;
            f32x4 fa = (f32x4){0.f, 0.f, 0.f, 0.f};
#pragma unroll
            for (int j = 0; j < 4; ++j) { const u32x2 hw = hr[64 * j];
                fa += wf[4 * j + 0] * bflo(hw.x); fa += wf[4 * j + 1] * bfhi(hw.x); fa += wf[4 * j + 2] * bflo(hw.y); fa += wf[4 * j + 3] * bfhi(hw.y); }
            fa.x = wave_sum(fa.x, lane); fa.y = wave_sum(fa.y, lane); fa.z = wave_sum(fa.z, lane); fa.w = wave_sum(fa.w, lane);
            if (lane == 0) {
                f32x4 o;
#pragma unroll
                for (int e = 0; e < 4; ++e) { const float t = fa[e] + bfv[e]; o[e] = fminf(t, 0.f) - log1pf(expf(-fabsf(t))); }
                *(f32x4*)(logf + (size_t)m * 4) = o;
            }
        }
        return;
    }
    for (int m = gw; m < M; m += NGW) {
        const f32x4* xr = (const f32x4*)(xin + (size_t)m * D) + lane;
        f32x4 v[4]; float s2 = 0.f;
#pragma unroll
        for (int j = 0; j < 4; ++j) { v[j] = __builtin_nontemporal_load(xr + 64 * j); s2 += (v[j].x * v[j].x + v[j].y * v[j].y) + (v[j].z * v[j].z + v[j].w * v[j].w); }
        const float rs = 1.0f / sqrtf(wave_sum(s2, lane) * (1.f / D) + RMS_EPS);
        f32x4 fa = (f32x4){0.f, 0.f, 0.f, 0.f};
        unsigned long long* o8 = (unsigned long long*)(H + (size_t)m * D) + lane;
#pragma unroll
        for (int j = 0; j < 4; ++j) {
            const f32x4 h = v[j] * rs * gv[j];
            fa += wf[4 * j + 0] * h.x; fa += wf[4 * j + 1] * h.y; fa += wf[4 * j + 2] * h.z; fa += wf[4 * j + 3] * h.w;
            o8[64 * j] = (unsigned long long)pk2(h.x, h.y) | ((unsigned long long)pk2(h.z, h.w) << 32);
        }
        fa.x = wave_sum(fa.x, lane); fa.y = wave_sum(fa.y, lane); fa.z = wave_sum(fa.z, lane); fa.w = wave_sum(fa.w, lane);
        if (lane == 0) {
            f32x4 o;
#pragma unroll
            for (int e = 0; e < 4; ++e) { const float t = fa[e] + bfv[e]; o[e] = fminf(t, 0.f) - log1pf(expf(-fabsf(t))); }
            *(f32x4*)(logf + (size_t)m * 4) = o;
        }
    }
}

__device__ __forceinline__ void cumsum_phase(const Args& a, int blk) {
    if (blk >= 8) return;
    int tid_ = threadIdx.x; asm volatile("" : "+v"(tid_));
    const int tid = tid_, lane = tid & 63, w = tid >> 6, seq = blk * 8 + w, b = seq >> 2, h = seq & 3;
    const float* lf = (const float*)(a.ws + WS_LOGF) + ((size_t)b * SEQ + 32 * lane) * 4 + h;
    float* cb = (float*)(a.ws + WS_CB) + (size_t)(b * 4 + h) * SEQ + 32 * lane;
    float v[32]; float run = 0.f;
#pragma unroll
    for (int i = 0; i < 32; ++i) { run += lf[4 * i]; v[i] = run; }
    float x = run;
#pragma unroll
    for (int o = 1; o < 64; o <<= 1) { const float t = bperm(x, lane >= o ? lane - o : lane); if (lane >= o) x += t; }
    const float excl = x - run;
#pragma unroll
    for (int i = 0; i < 32; i += 4) { f32x4 o4; o4.x = -LOG2E * (excl + v[i]); o4.y = -LOG2E * (excl + v[i + 1]); o4.z = -LOG2E * (excl + v[i + 2]); o4.w = -LOG2E * (excl + v[i + 3]); *(f32x4*)(cb + i) = o4; }
}

namespace attn {
constexpr int KPL = 2064;
constexpr int VPL = 8256;
constexpr int OFF_V = 8 * KPL;
constexpr int OFF_B = OFF_V + 2 * VPL;
constexpr int BUF = OFF_B + 512;
constexpr int NBUF = 3;
constexpr int OFF_WS = NBUF * BUF;
constexpr int OFF_ST = OFF_WS + 8 * 256;
constexpr int ST_BYTES = 32 * 144;
static_assert(OFF_ST + 8 * ST_BYTES <= LDS_BYTES - 256, "attention LDS map");

struct Item { int valid, type, b, h, qcol, kcol, vcol, zcol, ycol, dil, res0, M0, c0, c1, W; };

__device__ __forceinline__ Item make_item(int sub, int g, int j) {
    Item it; it.valid = 0; it.type = 0; it.b = 0; it.h = 0; it.qcol = 0; it.kcol = 0; it.vcol = 0; it.zcol = 0; it.ycol = 0; it.dil = 1; it.res0 = 0; it.M0 = 0; it.c0 = 0; it.c1 = 1; it.W = 128;
    if (sub == 0) {
        if (j >= 8) return it;
        it.valid = 1;
        if (j < 2) {
            const int bh = g >> 2, s = g & 3, qb = j == 0 ? s : 7 - s, h = bh & 3;
            it.type = 0; it.b = bh >> 2; it.h = h; it.qcol = 64 * h; it.kcol = 256 + 64 * h; it.vcol = 512 + 64 * h; it.zcol = 768 + 64 * h; it.ycol = 64 * h;
            it.M0 = 256 * qb; it.c0 = 0; it.c1 = 2 * (qb + 1); it.W = 1 << 30; return it;
        }
        const bool isC = j >= 5; const int idx = g * 3 + (j - (isC ? 5 : 2)), b = idx / 48, rem = idx % 48, h = rem >> 3, blk = rem & 7;
        it.b = b; it.h = h; it.M0 = 256 * blk; it.c0 = blk == 0 ? 1 : 0; it.c1 = 3;
        const int kvh = h / 3;
        it.type = isC ? 4 : 1; it.qcol = (isC ? 2560 : 1024) + 64 * h; it.kcol = isC ? 2944 + 64 * kvh : 1408 + 64 * h; it.vcol = isC ? 3072 + 64 * kvh : 1792 + 64 * h;
        it.zcol = (isC ? 3200 : 2176) + 64 * h; it.ycol = (isC ? 640 : 256) + 64 * h; it.W = isC ? 127 : 128;
        return it;
    }
    if (j >= 3) return it;
    it.valid = 1;
    const int idx = g * 3 + j, b = idx / 48, rem = idx % 48, h = rem >> 3, r8 = rem & 7;
    it.b = b; it.h = h; it.qcol = 1024 + 64 * h; it.kcol = 1408 + 64 * h; it.vcol = 1792 + 64 * h; it.zcol = 2176 + 64 * h; it.ycol = 256 + 64 * h; it.W = 128;
    const int blk = r8 & 1;
    it.type = sub == 1 ? 2 : 3; it.dil = sub == 1 ? 4 : 16; it.res0 = sub == 1 ? (r8 >> 1) : 2 * r8; it.M0 = sub == 1 ? 256 * blk : 0; it.c0 = (sub == 1 && blk == 0) ? 1 : 0; it.c1 = sub == 1 ? 3 : 2;
    return it;
}
__device__ __forceinline__ void chunk_src(const Item& it, int c, int& kp0, int& kres) {
    if (it.type == 0) { kp0 = 128 * c; kres = 0; }
    else if (it.type == 3) { kp0 = 0; kres = it.res0 + c; }
    else { kp0 = it.M0 - 128 + 128 * c; kres = it.res0; }
}
__device__ __forceinline__ s16x4 vtr(LAS const unsigned char* p) {
    typedef short v4i16_t __attribute__((ext_vector_type(4)));
    return __builtin_bit_cast(s16x4, __builtin_amdgcn_ds_read_tr16_b64_v4i16((LAS v4i16_t*)p));
}

__device__ __forceinline__ void attn_phase(const Args& a, int layer, int sub, LAS unsigned char* lds, int g) {
    int tid_ = threadIdx.x; asm volatile("" : "+v"(tid_));
    const int tid = tid_, lane = tid & 63, w = __builtin_amdgcn_readfirstlane(tid >> 6), hi = lane >> 5, l31 = lane & 31;
    const bf16_t* QKVZ = (const bf16_t*)(a.ws + WS_QKVZ); bf16_t* Y = (bf16_t*)(a.ws + WS_H); float* LSE = (float*)(a.ws + WS_LSE); const float* CB = (const float*)(a.ws + WS_CB);
    LAS float* wsf = (LAS float*)(lds + OFF_WS + w * 256);
    LAS bf16_t* stg = (LAS bf16_t*)(lds + OFF_ST + w * ST_BYTES);
    int j = 0, cb;
    { const Item it0 = make_item(sub, g, 0); if (!it0.valid) return; cb = it0.c0; }
    u32x4 kreg[NBUF][2], vreg[NBUF][2]; float breg[NBUF]; bf16x8 qn[4];
#define ATT_ISSUE(IT, CBEG, NCH) do { _Pragma("unroll") for (int ci_ = 0; ci_ < NBUF; ++ci_) if (ci_ < (NCH)) { int kp0_, kres_; chunk_src(IT, (CBEG) + ci_, kp0_, kres_); \
        _Pragma("unroll") for (int i_ = 0; i_ < 2; ++i_) { const int p_ = tid + 512 * i_, key_ = p_ >> 3, c16_ = p_ & 7; int m_ = kp0_ + key_; m_ = m_ < 0 ? 0 : m_; \
            const bf16_t* rp_ = QKVZ + (size_t)((IT).b * SEQ + m_ * (IT).dil + kres_) * NQ + c16_ * 8; \
            kreg[ci_][i_] = *(const u32x4*)(rp_ + (IT).kcol); vreg[ci_][i_] = *(const u32x4*)(rp_ + (IT).vcol); } \
        breg[ci_] = CB[(size_t)((IT).b * 4 + ((IT).h & 3)) * SEQ + ((kp0_ + (tid & 127)) & (SEQ - 1))]; } \
        if ((CBEG) == (IT).c0) { const int qres_ = (IT).type == 3 ? (IT).res0 + (w >> 2) : (IT).res0, mq0_ = (IT).type == 3 ? 32 * (w & 3) : (IT).M0 + 32 * w; \
            const bf16_t* qp_ = QKVZ + (size_t)((IT).b * SEQ + (mq0_ + l31) * (IT).dil + qres_) * NQ + (IT).qcol + 8 * hi; \
            _Pragma("unroll") for (int s_ = 0; s_ < 4; ++s_) qn[s_] = *(const bf16x8*)(qp_ + 16 * s_); } } while (0)
    { const Item it0 = make_item(sub, g, 0); const int n0 = it0.c1 - cb < NBUF ? it0.c1 - cb : NBUF; ATT_ISSUE(it0, cb, n0); }
    bf16x8 qf[4]; f32x16 o0, o1; float mrun = -1e30f, lrun = 0.f;
    for (;;) {
        const Item it = make_item(sub, g, j);
        const int nch = it.c1 - cb < NBUF ? it.c1 - cb : NBUF;
        int ncb = cb + nch, nj = j;
        if (ncb >= it.c1) nj = j + 1;
        const Item nx = make_item(sub, g, nj);
        const bool has_next = nx.valid != 0;
        if (nj != j) ncb = nx.c0;
        const int nnch = nx.c1 - ncb < NBUF ? nx.c1 - ncb : NBUF;
        __syncthreads();
#pragma unroll
        for (int ci = 0; ci < NBUF; ++ci) if (ci < nch) {
            LAS unsigned char* wb = lds + ci * BUF;
#pragma unroll
            for (int i = 0; i < 2; ++i) { const int p = tid + 512 * i, key = p >> 3, c16 = p & 7;
                *(LAS u32x4*)(wb + c16 * KPL + key * 16) = kreg[ci][i];
                *(LAS u32x4*)(wb + OFF_V + (c16 >> 2) * VPL + (key >> 3) * 512 + (key & 7) * 64 + (c16 & 3) * 16) = vreg[ci][i]; }
            if (tid < 128) *(LAS float*)(wb + OFF_B + tid * 4) = breg[ci];
        }
        __syncthreads();
        const int qres = it.type == 3 ? it.res0 + (w >> 2) : it.res0;
        const int mq0 = it.type == 3 ? 32 * (w & 3) : it.M0 + 32 * w;
        if (cb == it.c0) {
#pragma unroll
            for (int s = 0; s < 4; ++s) qf[s] = qn[s];
        }
        if (has_next) ATT_ISSUE(nx, ncb, nnch);
        if (cb == it.c0) {
#pragma unroll
            for (int r = 0; r < 16; ++r) { o0[r] = 0.f; o1[r] = 0.f; }
            mrun = -1e30f; lrun = 0.f;
        }
#pragma unroll 1
        for (int ci = 0; ci < nch; ++ci) {
        const int c = cb + ci;
        LAS unsigned char* buf = lds + ci * BUF;
        int kp0, kres; chunk_src(it, c, kp0, kres);
        if (kres == qres) {
#pragma unroll 1
            for (int jp = 0; jp < 2; ++jp) {
                const int a0 = kp0 + 64 * jp;
                if (a0 > mq0 + 31 || a0 + 63 < mq0 - it.W || a0 + 63 < 0) continue;
                const bool needmask = !(a0 + 63 <= mq0 && a0 >= mq0 + 31 - it.W && a0 >= 0);
                LAS const unsigned char* kb = buf + hi * KPL + (64 * jp + l31) * 16;
                const bf16x8 kf0 = *(LAS const bf16x8*)(kb), kf1 = *(LAS const bf16x8*)(kb + 2 * KPL), kf2 = *(LAS const bf16x8*)(kb + 4 * KPL), kf3 = *(LAS const bf16x8*)(kb + 6 * KPL);
                const bf16x8 kg0 = *(LAS const bf16x8*)(kb + 512), kg1 = *(LAS const bf16x8*)(kb + 512 + 2 * KPL), kg2 = *(LAS const bf16x8*)(kb + 512 + 4 * KPL), kg3 = *(LAS const bf16x8*)(kb + 512 + 6 * KPL);
                f32x16 s, t;
                if (it.type == 0) {
#pragma unroll
                    for (int g4 = 0; g4 < 4; ++g4) { const f32x4 bv = *(LAS const f32x4*)(buf + OFF_B + (64 * jp + 8 * g4 + 4 * hi) * 4), bw = *(LAS const f32x4*)(buf + OFF_B + (64 * jp + 32 + 8 * g4 + 4 * hi) * 4);
                        s[4 * g4] = bv.x; s[4 * g4 + 1] = bv.y; s[4 * g4 + 2] = bv.z; s[4 * g4 + 3] = bv.w; t[4 * g4] = bw.x; t[4 * g4 + 1] = bw.y; t[4 * g4 + 2] = bw.z; t[4 * g4 + 3] = bw.w; }
                    s = __builtin_amdgcn_mfma_f32_32x32x16_bf16(kf0, qf[0], s, 0, 0, 0);
                    t = __builtin_amdgcn_mfma_f32_32x32x16_bf16(kg0, qf[0], t, 0, 0, 0);
                } else {
                    const f32x16 z16 = {0.f, 0.f, 0.f, 0.f, 0.f, 0.f, 0.f, 0.f, 0.f, 0.f, 0.f, 0.f, 0.f, 0.f, 0.f, 0.f};
                    s = __builtin_amdgcn_mfma_f32_32x32x16_bf16(kf0, qf[0], z16, 0, 0, 0);
                    t = __builtin_amdgcn_mfma_f32_32x32x16_bf16(kg0, qf[0], z16, 0, 0, 0);
                }
                s = __builtin_amdgcn_mfma_f32_32x32x16_bf16(kf1, qf[1], s, 0, 0, 0);
                t = __builtin_amdgcn_mfma_f32_32x32x16_bf16(kg1, qf[1], t, 0, 0, 0);
                s = __builtin_amdgcn_mfma_f32_32x32x16_bf16(kf2, qf[2], s, 0, 0, 0);
                t = __builtin_amdgcn_mfma_f32_32x32x16_bf16(kg2, qf[2], t, 0, 0, 0);
                s = __builtin_amdgcn_mfma_f32_32x32x16_bf16(kf3, qf[3], s, 0, 0, 0);
                t = __builtin_amdgcn_mfma_f32_32x32x16_bf16(kg3, qf[3], t, 0, 0, 0);
                LAS const unsigned char* vb = buf + OFF_V + (8 * jp) * 512 + (4 * hi + ((lane & 15) >> 2)) * 64 + ((lane >> 4) & 1) * 32 + (lane & 3) * 8;
#define ATT_VF(cc, ks) ({ const s16x4 lo_ = vtr(vb + (cc) * VPL + (2 * (ks)) * 512), hi_ = vtr(vb + (cc) * VPL + (2 * (ks) + 1) * 512); (bf16x8){lo_[0], lo_[1], lo_[2], lo_[3], hi_[0], hi_[1], hi_[2], hi_[3]}; })
                const bf16x8 v00 = ATT_VF(0, 0), v01 = ATT_VF(0, 1), v02 = ATT_VF(0, 2), v03 = ATT_VF(0, 3), v10 = ATT_VF(1, 0), v11 = ATT_VF(1, 1), v12 = ATT_VF(1, 2), v13 = ATT_VF(1, 3);
#undef ATT_VF
                if (needmask) {
                    const int qpos = mq0 + l31;
#pragma unroll
                    for (int r = 0; r < 16; ++r) { const int kpos = a0 + (r & 3) + 8 * (r >> 2) + 4 * hi; const bool ok = kpos >= 0 && kpos <= qpos && qpos - kpos <= it.W; s[r] = ok ? s[r] : -INFINITY;
                        const int kp2 = kpos + 32; const bool ok2 = kp2 >= 0 && kp2 <= qpos && qpos - kp2 <= it.W; t[r] = ok2 ? t[r] : -INFINITY; }
                }
                float mx = __builtin_fmaxf(__builtin_fmaxf(s[0], s[1]), t[0]), my = __builtin_fmaxf(__builtin_fmaxf(s[2], s[3]), t[1]);
                mx = __builtin_fmaxf(__builtin_fmaxf(mx, t[2]), t[3]);
#pragma unroll
                for (int r = 4; r < 16; r += 4) { mx = __builtin_fmaxf(__builtin_fmaxf(mx, s[r]), s[r + 1]); my = __builtin_fmaxf(__builtin_fmaxf(my, s[r + 2]), s[r + 3]); mx = __builtin_fmaxf(__builtin_fmaxf(mx, t[r]), t[r + 1]); my = __builtin_fmaxf(__builtin_fmaxf(my, t[r + 2]), t[r + 3]); }
                mx = __builtin_fmaxf(mx, my);
                { const auto rr = __builtin_amdgcn_permlane32_swap(__float_as_uint(mx), __float_as_uint(mx), false, false); mx = fmaxf(__uint_as_float(rr[0]), __uint_as_float(rr[1])); }
                const float mnew = fmaxf(mrun, mx);
                if (__any(mx > mrun + 16.0f)) {
                    const float alpha = ex2(mrun - mnew); lrun *= alpha; mrun = mnew;
                    if (hi == 0) wsf[l31] = alpha;
#pragma unroll
                    for (int g4 = 0; g4 < 4; ++g4) { const f32x4 av = *(LAS const f32x4*)(wsf + 8 * g4 + 4 * hi);
                        o0[4 * g4] *= av.x; o0[4 * g4 + 1] *= av.y; o0[4 * g4 + 2] *= av.z; o0[4 * g4 + 3] *= av.w;
                        o1[4 * g4] *= av.x; o1[4 * g4 + 1] *= av.y; o1[4 * g4 + 2] *= av.z; o1[4 * g4 + 3] *= av.w; }
                }
                float ps = 0.f, pt = 0.f;
#pragma unroll
                for (int r = 0; r < 16; ++r) { s[r] = ex2(s[r] - mrun); ps += s[r]; t[r] = ex2(t[r] - mrun); pt += t[r]; }
                lrun += ps + pt;
                u32x4 pw0, pw1, pw2, pw3;
                pw0.x = pk2(s[0], s[1]); pw0.y = pk2(s[2], s[3]); pw0.z = pk2(s[4], s[5]); pw0.w = pk2(s[6], s[7]);
                pw1.x = pk2(s[8], s[9]); pw1.y = pk2(s[10], s[11]); pw1.z = pk2(s[12], s[13]); pw1.w = pk2(s[14], s[15]);
                pw2.x = pk2(t[0], t[1]); pw2.y = pk2(t[2], t[3]); pw2.z = pk2(t[4], t[5]); pw2.w = pk2(t[6], t[7]);
                pw3.x = pk2(t[8], t[9]); pw3.y = pk2(t[10], t[11]); pw3.z = pk2(t[12], t[13]); pw3.w = pk2(t[14], t[15]);
                const bf16x8 pa0 = __builtin_bit_cast(bf16x8, pw0), pa1 = __builtin_bit_cast(bf16x8, pw1), pa2 = __builtin_bit_cast(bf16x8, pw2), pa3 = __builtin_bit_cast(bf16x8, pw3);
                o0 = __builtin_amdgcn_mfma_f32_32x32x16_bf16(pa0, v00, o0, 0, 0, 0);
                o1 = __builtin_amdgcn_mfma_f32_32x32x16_bf16(pa0, v10, o1, 0, 0, 0);
                o0 = __builtin_amdgcn_mfma_f32_32x32x16_bf16(pa1, v01, o0, 0, 0, 0);
                o1 = __builtin_amdgcn_mfma_f32_32x32x16_bf16(pa1, v11, o1, 0, 0, 0);
                o0 = __builtin_amdgcn_mfma_f32_32x32x16_bf16(pa2, v02, o0, 0, 0, 0);
                o1 = __builtin_amdgcn_mfma_f32_32x32x16_bf16(pa2, v12, o1, 0, 0, 0);
                o0 = __builtin_amdgcn_mfma_f32_32x32x16_bf16(pa3, v03, o0, 0, 0, 0);
                o1 = __builtin_amdgcn_mfma_f32_32x32x16_bf16(pa3, v13, o1, 0, 0, 0);
            }
        }
        }
        if (cb + nch == it.c1) {
            float lt; { const auto rr = __builtin_amdgcn_permlane32_swap(__float_as_uint(lrun), __float_as_uint(lrun), false, false); lt = __uint_as_float(rr[0]) + __uint_as_float(rr[1]); }
            float scale, L2 = 0.f;
            if (it.type == 4) { const float sink2 = a.sinks[layer * 6 + it.h] * LOG2E, mf = fmaxf(mrun, sink2), al = ex2(mrun - mf); scale = al / (lt * al + ex2(sink2 - mf)); }
            else { scale = 1.f / lt; L2 = mrun + log2f(lt); }
            if (hi == 0) { wsf[l31] = scale; wsf[32 + l31] = L2; }
#pragma unroll
            for (int g4 = 0; g4 < 4; ++g4) { const f32x4 av = *(LAS const f32x4*)(wsf + 8 * g4 + 4 * hi);
#pragma unroll
                for (int e = 0; e < 4; ++e) { const int r = 4 * g4 + e, row = 8 * g4 + 4 * hi + e;
                    stg[row * 72 + l31] = (bf16_t)f2bf(o0[r] * av[e]); stg[row * 72 + 32 + l31] = (bf16_t)f2bf(o1[r] * av[e]); } }
#pragma unroll
            for (int i = 0; i < 4; ++i) {
                const int row = i * 8 + (lane >> 3), ch = lane & 7;
                const u32x4 ov = *(LAS const u32x4*)(stg + row * 72 + ch * 8);
                const size_t tok = (size_t)(it.b * SEQ + (mq0 + row) * it.dil + qres);
                bf16_t* yp = Y + tok * 1024 + it.ycol + ch * 8;
                float f[8] = {bflo(ov.x), bfhi(ov.x), bflo(ov.y), bfhi(ov.y), bflo(ov.z), bfhi(ov.z), bflo(ov.w), bfhi(ov.w)};
                if (it.type == 1) { if (ch == 0) LSE[tok * 6 + it.h] = wsf[32 + row]; }
                if (it.type == 2 || it.type == 3) {
                    const u32x4 od = *(const u32x4*)yp; const float Lold = LSE[tok * 6 + it.h], Lnew = wsf[32 + row], Lm = fmaxf(Lold, Lnew);
                    float wo = ex2(Lold - Lm), wn = ex2(Lnew - Lm); const float sw = wo + wn, inv = 1.f / sw; wo *= inv; wn *= inv;
                    const float q[8] = {bflo(od.x), bfhi(od.x), bflo(od.y), bfhi(od.y), bflo(od.z), bfhi(od.z), bflo(od.w), bfhi(od.w)};
#pragma unroll
                    for (int e = 0; e < 8; ++e) f[e] = wo * q[e] + wn * f[e];
                    if (it.type == 2 && ch == 0) LSE[tok * 6 + it.h] = Lm + log2f(sw);
                }
                if (it.type == 0 || it.type >= 3) {
                    const u32x4 zv = *(const u32x4*)(QKVZ + tok * NQ + it.zcol + ch * 8);
                    const float z[8] = {bflo(zv.x), bfhi(zv.x), bflo(zv.y), bfhi(zv.y), bflo(zv.z), bfhi(zv.z), bflo(zv.w), bfhi(zv.w)};
#pragma unroll
                    for (int e = 0; e < 8; ++e) f[e] *= z[e];
                }
                u32x4 wv; wv.x = pk2(f[0], f[1]); wv.y = pk2(f[2], f[3]); wv.z = pk2(f[4], f[5]); wv.w = pk2(f[6], f[7]);
                *(u32x4*)yp = wv;
            }
        }
        if (!has_next) break;
        cb = ncb; j = nj;
    }
#undef ATT_ISSUE
}
}

__device__ __forceinline__ void final_norm_phase(const Args& a, int vcu, int G) {
    int tid_ = threadIdx.x; asm volatile("" : "+v"(tid_));
    const int tid = tid_, lane = tid & 63, wave = tid >> 6, gw = vcu * 8 + wave, NGW = G * 8;
    f32x4 gv[4];
#pragma unroll
    for (int j = 0; j < 4; ++j) gv[j] = *(const f32x4*)(a.final_g + 256 * j + 4 * lane);
    for (int m = gw; m < M; m += NGW) {
        f32x4* xr = (f32x4*)(a.out + (size_t)m * D) + lane;
        f32x4 v[4]; float s2 = 0.f;
#pragma unroll
        for (int j = 0; j < 4; ++j) { v[j] = xr[64 * j]; s2 += (v[j].x * v[j].x + v[j].y * v[j].y) + (v[j].z * v[j].z + v[j].w * v[j].w); }
        const float rs = 1.0f / sqrtf(wave_sum(s2, lane) * (1.f / D) + RMS_EPS);
#pragma unroll
        for (int j = 0; j < 4; ++j) xr[64 * j] = v[j] * rs * gv[j];
    }
}


#define XB_TMO      128
#define XB_XCNT(j)  (256  + 64 * (j))
#define XB_XSUB(j)  (1280 + 64 * (j))
#define XB_XGEN(j)  (2304 + 64 * (j))
#define XB_TOP      3328
#define XB_TOPGEN   3392
#define XCD_BAR_WORDS 3456
#define XB_SPIN_CAP (1u << 18)
__device__ __forceinline__ unsigned xb_ld(unsigned* p)              { return __hip_atomic_load(p, __ATOMIC_RELAXED, __HIP_MEMORY_SCOPE_AGENT); }
__device__ __forceinline__ unsigned xb_add(unsigned* p, unsigned v) { return __hip_atomic_fetch_add(p, v, __ATOMIC_RELAXED, __HIP_MEMORY_SCOPE_AGENT); }
__device__ __forceinline__ unsigned xb_xcc_id() { return (unsigned)__builtin_amdgcn_s_getreg((3 << 11) | 20) & 0xFu; }
#define XB_SPIN(cond, bar) do { unsigned _sp = 0; while (cond) { __builtin_amdgcn_s_sleep(1); \
    if ((++_sp & 255u) == 0u) { if (xb_ld(&(bar)[XB_TMO])) break; if (_sp > XB_SPIN_CAP) { atomicAdd(&(bar)[XB_TMO], 1u); break; } } } } while (0)
struct XcdBarrier { unsigned* bar; unsigned x; volatile LAS unsigned* st; };
__device__ __forceinline__ XcdBarrier xcd_barrier_post(unsigned* bar, volatile LAS unsigned* st) {
    XcdBarrier b; b.bar = bar; b.x = xb_xcc_id(); b.st = st;
    if (threadIdx.x == 0) (void)xb_add(&bar[XB_XCNT(b.x)], 1u);
    return b;
}
__device__ __forceinline__ void xcd_barrier_complete(unsigned* bar, unsigned x, unsigned& nloc, unsigned& nx) {
    const unsigned G = gridDim.x * gridDim.y * gridDim.z;
    unsigned sum, cnt, mine, sp = 0u;
    for (;;) {
        sum = 0u; cnt = 0u; mine = 0u;
#pragma unroll
        for (unsigned j = 0; j < 16; ++j) { const unsigned c = xb_ld(&bar[XB_XCNT(j)]); sum += c; cnt += (c > 0u) ? 1u : 0u; mine = (j == x) ? c : mine; }
        if (sum == G) break;
        __builtin_amdgcn_s_sleep(1);
        if ((++sp & 255u) == 0u) { if (xb_ld(&bar[XB_TMO])) break; if (sp > XB_SPIN_CAP) { atomicAdd(&bar[XB_TMO], 1u); break; } }
    }
    nloc = mine > 0u ? mine : 1u; nx = cnt > 0u ? cnt : 1u;
}
__device__ __forceinline__ void xcd_barrier(const XcdBarrier& b) {
    asm volatile("s_waitcnt vmcnt(0)" ::: "memory");
    __syncthreads();
    if (threadIdx.x == 0) {
        unsigned* bar = b.bar;
        __builtin_amdgcn_s_waitcnt(0);
        unsigned nloc = b.st[0], nx = b.st[1];
        if (nloc == 0u) { xcd_barrier_complete(bar, b.x, nloc, nx); b.st[0] = nloc; b.st[1] = nx; }
        const unsigned old = xb_add(&bar[XB_XSUB(b.x)], 1u);
        const unsigned gen = old / nloc;
        if (old + 1u == (gen + 1u) * nloc) {
            __builtin_amdgcn_fence(__ATOMIC_RELEASE, "agent");
            asm volatile("s_waitcnt vmcnt(0)" ::: "memory");
            const unsigned og = xb_add(&bar[XB_TOP], 1u);
            const unsigned tg = og / nx;
            if (og + 1u == (tg + 1u) * nx) xb_add(&bar[XB_TOPGEN], 1u);
            else XB_SPIN(xb_ld(&bar[XB_TOPGEN]) == tg, bar);
            __builtin_amdgcn_fence(__ATOMIC_ACQUIRE, "agent");
            xb_add(&bar[XB_XGEN(b.x)], 1u);
            asm volatile("s_waitcnt vmcnt(0)" ::: "memory");
        } else {
            XB_SPIN(xb_ld(&bar[XB_XGEN(b.x)]) == gen, bar);
            __builtin_amdgcn_fence(__ATOMIC_ACQUIRE, "agent");
            asm volatile("s_waitcnt vmcnt(0)" ::: "memory");
        }
    }
    __syncthreads();
}

__global__ void __launch_bounds__(NTHREADS, 2) fwd_megakernel(Args a) {
    extern __shared__ __attribute__((aligned(16))) unsigned char lds_raw[];
    cg::grid_group grid = cg::this_grid();
    LAS unsigned char* lds = (LAS unsigned char*)lds_raw;
    const int G = gridDim.x, bx = blockIdx.x;
    const int vcu = (G % 8 == 0) ? (bx % 8) * (G / 8) + bx / 8 : bx;
    unsigned char* ws = a.ws;
    if (ws == nullptr) grid.sync();
    volatile LAS unsigned* bst = (volatile LAS unsigned*)(lds + LDS_BYTES - 64);
    if (threadIdx.x < 2) bst[threadIdx.x] = 0u;
    __syncthreads();
    const XcdBarrier bar = xcd_barrier_post((unsigned*)ws, bst);
#pragma unroll 1
    for (int step = 0; step < 14; ++step) {
        const int layer = step / 7, ph = step - 7 * layer;
#ifndef NO_PREP
        if (ph == 0) { for (int rep = 0; rep < PROBE_REP_PREP; ++rep) prep_phase(a, layer, lds, vcu, G); }
        else
#endif
        if (ph == 1 || ph >= 5) {
#ifndef NO_GEMM
            if (ph == 1) cumsum_phase(a, bx);
            pg8::Sched S; S.kind = ph == 1 ? 0 : (ph == 5 ? 1 : 2); S.so.init(M, ph == 1 ? NP : 1024, G, bx);
            pg8::Epi E; E.QKVZ = (bf16_t*)(ws + WS_QKVZ); E.Gt = (bf16_t*)(ws + WS_G); E.MERGED = (bf16_t*)(ws + WS_QKVZ);
            E.xin = layer == 0 ? a.x : a.out; E.xout = a.out; E.cosT = (const float*)(ws + WS_COS); E.sinT = (const float*)(ws + WS_SIN);
            E.gfin = layer == 0 ? a.norm_g + D : a.final_g; E.Hout = (bf16_t*)(ws + WS_H); E.slots = (unsigned*)(ws + WS_SLOTS); E.cnt = (unsigned*)(ws + 16384 + layer * 32768); E.xl = lds + 131072;
            const bf16_t* A = ph == 1 ? (const bf16_t*)(ws + WS_H) : (ph == 5 ? (const bf16_t*)(ws + WS_H) : (const bf16_t*)(ws + WS_QKVZ));
            const bf16_t* Bt = ph == 1 ? (const bf16_t*)(ws + WS_WIN) : (ph == 5 ? (const bf16_t*)(ws + WS_WBR) : (const bf16_t*)(ws + WS_WOUT));
#ifdef ONLY_KIND
            pg8::gemm_phase<ONLY_KIND>(lds, A, Bt, S, E);
#else
            if (ph == 1) { for (int rep = 0; rep < PROBE_REP_GEMM1; ++rep) pg8::gemm_phase<0>(lds, A, Bt, S, E); } else if (ph == 5) { for (int rep = 0; rep < PROBE_REP_MERGE; ++rep) pg8::gemm_phase<1>(lds, A, Bt, S, E); } else if (layer == 0) pg8::gemm_phase<4>(lds, A, Bt, S, E); else pg8::gemm_phase<3>(lds, A, Bt, S, E);
#endif
#endif
        }
#ifndef NO_ATTN
        else { const int nrep = ph == 2 ? PROBE_REP_ATT0 : 1; for (int rep = 0; rep < nrep; ++rep) { attn::attn_phase(a, layer, ph - 2, lds, vcu); __syncthreads(); } }
#endif
        if (step == 13) break;
        xcd_barrier(bar);
#ifdef PROBE_SYNC2
        xcd_barrier(bar);
#endif
    }
}

extern "C" void kernel_launch(void* const* d_in, const int* in_sizes, int n_in, void* d_out, int out_size, void* d_ws, size_t ws_size, hipStream_t stream) {
    static int grid = 0;
    if (grid == 0) {
        if (n_in != 10 || in_sizes[0] != M * D || out_size != M * D || ws_size < WS_END) { fprintf(stderr, "kernel_launch: unexpected shapes/workspace (n_in %d, in0 %d, out %d, ws %zu)\n", n_in, n_in > 0 ? in_sizes[0] : -1, out_size, ws_size); grid = -1; return; }
        int dev = 0, cus = 0, per_cu = 0;
        if (hipGetDevice(&dev) != hipSuccess || hipDeviceGetAttribute(&cus, hipDeviceAttributeMultiprocessorCount, dev) != hipSuccess) { grid = -1; return; }
        if (hipFuncSetAttribute((const void*)fwd_megakernel, hipFuncAttributeMaxDynamicSharedMemorySize, LDS_BYTES) != hipSuccess) { fprintf(stderr, "kernel_launch: hipFuncSetAttribute failed\n"); grid = -1; return; }
        if (hipOccupancyMaxActiveBlocksPerMultiprocessor(&per_cu, (const void*)fwd_megakernel, NTHREADS, LDS_BYTES) != hipSuccess || per_cu < 1) { fprintf(stderr, "kernel_launch: occupancy query gave %d\n", per_cu); (void)hipGetLastError(); per_cu = 1; }
        grid = cus * (per_cu > 1 ? 1 : per_cu);
    }
    if (grid < 0) return;
    if (hipMemsetAsync(d_ws, 0, 131072, stream) != hipSuccess) { fprintf(stderr, "kernel_launch: memset of barrier words failed\n"); return; }
    Args a{};
    a.x = (const float*)d_in[0]; a.norm_g = (const float*)d_in[1]; a.w_in = (const float*)d_in[2]; a.b_forget = (const float*)d_in[3]; a.sinks = (const float*)d_in[4];
    a.w_br_a = (const float*)d_in[5]; a.w_br_b = (const float*)d_in[6]; a.w_br_c = (const float*)d_in[7]; a.w_out = (const float*)d_in[8]; a.final_g = (const float*)d_in[9];
    a.out = (float*)d_out; a.ws = (unsigned char*)d_ws;
    for (int i = 0; i < 32; ++i) a.inv_freq[i] = powf(10000.0f, -(float)(2 * i) / 64.0f);
    void* args[] = {&a};
    hipError_t e = hipLaunchCooperativeKernel((const void*)fwd_megakernel, dim3(grid), dim3(NTHREADS), args, LDS_BYTES, stream);
    if (e != hipSuccess) fprintf(stderr, "kernel_launch: cooperative launch failed: %s (grid %d)\n", hipGetErrorString(e), grid);
}
```

```cpp
#include <hip/hip_runtime.h>
#include <hip/hip_cooperative_groups.h>
#include <cstdio>
#include <cstdint>
#include <cmath>
namespace cg = cooperative_groups;

#define LAS __attribute__((address_space(3)))
#define GAS __attribute__((address_space(1)))
typedef unsigned short bf16_t;
typedef short bf16x8 __attribute__((ext_vector_type(8)));
typedef short s16x4 __attribute__((ext_vector_type(4)));
typedef float f32x4 __attribute__((ext_vector_type(4)));
typedef float f32x16 __attribute__((ext_vector_type(16)));
typedef unsigned u32x4 __attribute__((ext_vector_type(4)));
typedef unsigned u32x2 __attribute__((ext_vector_type(2)));

constexpr int SEQ = 2048, NBATCH = 16, M = NBATCH * SEQ, D = 1024;
constexpr int NIN = 6660;
constexpr int NP = 6656;
constexpr int NQ = 2048;
constexpr size_t KVH_OFF = (size_t)M * NQ * 2;
constexpr int NGC = 3072;
constexpr float LOG2E = 1.4426950408889634f;
constexpr float C2 = 0.125f * LOG2E;
constexpr float RMS_EPS = 1e-6f;

constexpr size_t MiB = 1u << 20;
constexpr size_t WS_COS = 1 * MiB;
constexpr size_t WS_SIN = WS_COS + 256 * 1024;
constexpr size_t WS_LOGF = WS_SIN + 256 * 1024;
constexpr size_t WS_CB = WS_LOGF + 512 * 1024;
constexpr size_t WS_LSE = WS_CB + 512 * 1024;
constexpr size_t WS_SLOTS = 512 * 1024;
constexpr size_t WS_WIN = 4 * MiB;
constexpr size_t WS_WBR = 17 * MiB;
constexpr size_t WS_WOUT = 19 * MiB;
constexpr size_t WS_H = 22 * MiB;
constexpr size_t WS_QKVZ = 86 * MiB;
constexpr size_t WS_G = 310 * MiB;
constexpr size_t WS_END = 502 * MiB;

constexpr int LDS_BYTES = 147456;
constexpr int NTHREADS = 512;
#ifndef PROBE_REP_GEMM1
#define PROBE_REP_GEMM1 1
#endif
#ifndef PROBE_REP_MERGE
#define PROBE_REP_MERGE 1
#endif
#ifndef PROBE_REP_PREP
#define PROBE_REP_PREP 1
#endif
#ifndef PROBE_REP_ATT0
#define PROBE_REP_ATT0 1
#endif

__device__ __forceinline__ unsigned f2bf(float f) { unsigned u = __builtin_bit_cast(unsigned, f); return (u + 0x7fffu + ((u >> 16) & 1u)) >> 16; }
typedef float f32x2_t __attribute__((ext_vector_type(2))); typedef __bf16 bf16x2_t __attribute__((ext_vector_type(2)));
__device__ __forceinline__ unsigned pk2(float lo, float hi) { f32x2_t v = {lo, hi}; bf16x2_t b = __builtin_convertvector(v, bf16x2_t); return __builtin_bit_cast(unsigned, b); }
__device__ __forceinline__ float bflo(unsigned w) { return __builtin_bit_cast(float, w << 16); }
__device__ __forceinline__ float bfhi(unsigned w) { return __builtin_bit_cast(float, w & 0xffff0000u); }
__device__ __forceinline__ float ex2(float x) { return __builtin_amdgcn_exp2f(x); }
__device__ __forceinline__ float rcpf_(float x) { return __builtin_amdgcn_rcpf(x); }
__device__ __forceinline__ float bperm(float v, int src_lane) { return __builtin_bit_cast(float, __builtin_amdgcn_ds_bpermute(src_lane << 2, __builtin_bit_cast(int, v))); }

namespace pg8 {
constexpr int BM = 256, BK = 64, HALF = 128, HTB = HALF * BK * 2, STAGE_BYTES = 8 * HTB, NXCD = 8, WGM = 8, LD = 1024;
__device__ __forceinline__ int lds_byte(int r, int c) { const int st = (r >> 4) * 2 + (c >> 5), rr = r & 15, cc = c & 31, ob = rr * 64 + cc * 2; return st * 1024 + (ob ^ (((ob >> 9) & 1) << 5)); }
__device__ __forceinline__ void stage_rc(int b, int& R, int& C) { const int st = b / 1024, sb = b % 1024, swz = sb ^ (((sb >> 9) & 1) << 5); R = (st >> 1) * 16 + swz / 64; C = (st & 1) * 32 + (swz % 64) / 2; }
__device__ __forceinline__ int perm32(int rho) { const int n = rho >> 4, i = rho & 15; return 8 * (i >> 2) + 4 * n + (i & 3); }

struct Unit { int pm, pn, k0, nt, mode; };

struct StaticOrder {
    int nM, nN, nwg, G, c;
    __device__ void init(int M_, int N_, int G_, int c_) { nM = M_ / BM; nN = N_ / BM; nwg = nM * nN; G = G_; c = c_; }
    __device__ bool next(int i, Unit& u) const {
        const long L = (long)i * G + c; if (L >= nwg) return false;
        int wgid = (int)L; { const int q = nwg / NXCD, r = nwg % NXCD, xcd = wgid % NXCD, off = wgid / NXCD; wgid = (xcd < r ? xcd * (q + 1) : r * (q + 1) + (xcd - r) * q) + off; }
        const int nig = WGM * nN, gid = wgid / nig, fm = gid * WGM, gsz = (nM - fm) < WGM ? (nM - fm) : WGM;
        u.pm = fm + ((wgid % nig) % gsz); u.pn = (wgid % nig) / gsz; return true;
    }
};
struct Sched {
    StaticOrder so; int kind;
    __device__ bool next(int i, Unit& u) const {
        if (kind == 1) { const int t = i / 3, br = i - 3 * t; if (!so.next(t, u)) return false; u.k0 = br == 0 ? 0 : (br == 1 ? 256 : 640); u.nt = br == 0 ? 4 : 6; u.mode = 1 + br; return true; }
        if (!so.next(i, u)) return false; u.k0 = 0; u.nt = 16; u.mode = kind == 0 ? 0 : 4; return true;
    }
};

struct Epi {
    bf16_t* QKVZ; bf16_t* Gt; bf16_t* MERGED; const float* xin; float* xout; const float* cosT; const float* sinT;
    const float* gfin; bf16_t* Hout; unsigned* slots; unsigned* cnt; LAS unsigned char* xl;
    __device__ __forceinline__ static int blockop(int blk) {
        if (blk >= 28) return 3;
        if (blk < 8) return blk < 2 ? 1 : (blk < 6 ? 0 : 2);
        if (blk < 20) { const int t = blk - 8; return t < 3 ? 5 : (t < 6 ? 4 : (t < 9 ? 0 : 2)); }
        const int t = blk - 20; return t < 3 ? 5 : (t == 3 ? 4 : (t == 4 ? 0 : 2));
    }
    template <int KIND> __device__ __forceinline__ void run(f32x4 (&acc)[2][2][4][2], const Unit& u, int wr, int wc, int fr, int fq) const {
        const int rl = wr * 64 + fr, cl = wc * 32 + 8 * fq;
        if constexpr (KIND == 1) {
            const int br = u.mode - 1;
            const char* gbase = (const char*)(Gt + br * 1024 + u.pn * BM) + (size_t)u.pm * BM * NGC * 2;
            unsigned goff = (unsigned)(rl * NGC + cl) * 2u;
            const int gnext = br < 2 ? 2048 : 0;
            const bool rt = br < 2;
#pragma unroll
            for (int bj = 0; bj < 2; ++bj)
#pragma unroll
                for (int ai = 0; ai < 2; ++ai) {
                    u32x4 ga[4], gb[4];
#pragma unroll
                    for (int m = 0; m < 4; ++m) { const char* gp = gbase + (size_t)(ai * HALF + m * 16) * NGC * 2 + bj * 256 + goff; ga[m] = *(const u32x4*)gp; gb[m] = *(const u32x4*)(gp + gnext); }
#pragma unroll
                    for (int m = 0; m < 4; ++m) {
                        f32x4 f0, f1;
                        f0[0] = bflo(ga[m].x) * (rt ? rcpf_(bflo(gb[m].x)) : 1.f); f0[1] = bfhi(ga[m].x) * (rt ? rcpf_(bfhi(gb[m].x)) : 1.f); f0[2] = bflo(ga[m].y) * (rt ? rcpf_(bflo(gb[m].y)) : 1.f); f0[3] = bfhi(ga[m].y) * (rt ? rcpf_(bfhi(gb[m].y)) : 1.f);
                        f1[0] = bflo(ga[m].z) * (rt ? rcpf_(bflo(gb[m].z)) : 1.f); f1[1] = bfhi(ga[m].z) * (rt ? rcpf_(bfhi(gb[m].z)) : 1.f); f1[2] = bflo(ga[m].w) * (rt ? rcpf_(bflo(gb[m].w)) : 1.f); f1[3] = bfhi(ga[m].w) * (rt ? rcpf_(bfhi(gb[m].w)) : 1.f);
#define PKMUL_INPLACE(A, F) do { f32x2_t lo_ = {(A)[0], (A)[1]}, hi_ = {(A)[2], (A)[3]}; const f32x2_t fl_ = {(F)[0], (F)[1]}, fh_ = {(F)[2], (F)[3]}; \
        asm volatile("v_pk_mul_f32 %0, %0, %1" : "+v"(lo_) : "v"(fl_)); asm volatile("v_pk_mul_f32 %0, %0, %1" : "+v"(hi_) : "v"(fh_)); (A) = (f32x4){lo_[0], lo_[1], hi_[0], hi_[1]}; } while (0)
                        PKMUL_INPLACE(acc[ai][bj][m][0], f0); PKMUL_INPLACE(acc[ai][bj][m][1], f1);
                    }
                    asm volatile("" : "+v"(goff));
                }
            if (br == 2) {
                char* mbase = (char*)(MERGED + u.pn * BM) + (size_t)u.pm * BM * 1024 * 2;
                const unsigned moff = (unsigned)(rl * 1024 + cl) * 2u;
#pragma unroll
                for (int bj = 0; bj < 2; ++bj)
#pragma unroll
                    for (int ai = 0; ai < 2; ++ai)
#pragma unroll
                        for (int m = 0; m < 4; ++m) {
                            const f32x4 v0 = acc[ai][bj][m][0], v1 = acc[ai][bj][m][1];
                            u32x4 w; w.x = pk2(v0[0], v0[1]); w.y = pk2(v0[2], v0[3]); w.z = pk2(v1[0], v1[1]); w.w = pk2(v1[2], v1[3]);
                            *(u32x4*)(mbase + (size_t)(ai * HALF + m * 16) * 2048 + bj * 256 + moff) = w;
                        }
            }
            const float keep = br == 2 ? 0.f : 1.f;
#pragma unroll
            for (int bj = 0; bj < 2; ++bj)
#pragma unroll
                for (int ai = 0; ai < 2; ++ai)
#pragma unroll
                    for (int m = 0; m < 4; ++m) { const f32x4 k4 = (f32x4){keep, keep, keep, keep}; PKMUL_INPLACE(acc[ai][bj][m][0], k4); PKMUL_INPLACE(acc[ai][bj][m][1], k4); }
            return;
        }
        if constexpr (KIND == 0) {
            const unsigned toff = (unsigned)(rl * 32 + 16 * (wc & 1) + 4 * fq) * 4u;
            const char* cbase = (const char*)cosT + (size_t)((u.pm & 7) * 256) * 128; const char* sbase = (const char*)sinT + (size_t)((u.pm & 7) * 256) * 128;
#pragma unroll
            for (int bj = 0; bj < 2; ++bj) {
                const int blk = 2 * u.pn + bj, op = blockop(blk);
                int ld; char* base; unsigned voff;
                if (blk >= 28) { ld = NGC; base = (char*)(Gt + (blk - 28) * 128) + (size_t)u.pm * BM * ld * 2; voff = (unsigned)(rl * ld + cl) * 2u; }
                else if (op == 0 || op == 4) {
                    const int plane0 = blk < 4 ? (blk - 2) * 2 : (blk < 6 ? 12 + (blk - 4) * 2 : (blk < 14 ? 4 + (blk - 11) * 2 : (blk < 17 ? 16 + (blk - 14) * 2 : (blk == 23 ? 10 : 22))));
                    ld = 64; base = (char*)QKVZ + KVH_OFF + ((size_t)((plane0 + (wc >> 1)) * NBATCH + (u.pm >> 3)) * SEQ + (size_t)(u.pm & 7) * BM) * 128;
                    voff = (unsigned)(rl * 64 + (wc & 1) * 32 + 8 * fq) * 2u;
                } else {
                    const int qzc = blk < 2 ? blk * 128 : (blk < 8 ? 256 + (blk - 6) * 128 : (blk < 11 ? 512 + (blk - 8) * 128 : (blk < 20 ? 896 + (blk - 17) * 128 : (blk < 23 ? 1280 + (blk - 20) * 128 : 1664 + (blk - 25) * 128))));
                    ld = NQ; base = (char*)(QKVZ + qzc) + (size_t)u.pm * BM * ld * 2; voff = (unsigned)(rl * ld + cl) * 2u;
                }
                if (op >= 4) {
                    const float sc = op == 5 ? C2 : 1.f;
                    f32x4 c4[8], s4[8];
#pragma unroll
                    for (int q = 0; q < 8; ++q) { const int dr = (q >> 2) * HALF + (q & 3) * 16; c4[q] = *(const f32x4*)(cbase + dr * 128 + toff); s4[q] = *(const f32x4*)(sbase + dr * 128 + toff); }
                    asm volatile("" ::: "memory");
#pragma unroll
                    for (int q = 0; q < 8; ++q) {
                        const int ai = q >> 2, m = q & 3, dr = ai * HALF + m * 16;
                        const f32x4 v0 = acc[ai][bj][m][0], v1 = acc[ai][bj][m][1];
                        const f32x4 cc = c4[q] * sc, ss = s4[q] * sc;
                        u32x4 w;
                        w.x = pk2(v0[0] * cc[0] - v0[1] * ss[0], v0[1] * cc[0] + v0[0] * ss[0]);
                        w.y = pk2(v0[2] * cc[1] - v0[3] * ss[1], v0[3] * cc[1] + v0[2] * ss[1]);
                        w.z = pk2(v1[0] * cc[2] - v1[1] * ss[2], v1[1] * cc[2] + v1[0] * ss[2]);
                        w.w = pk2(v1[2] * cc[3] - v1[3] * ss[3], v1[3] * cc[3] + v1[2] * ss[3]);
                        __builtin_nontemporal_store(w, (u32x4*)(base + (size_t)dr * ld * 2 + voff));
                    }
                    asm volatile("" ::: "memory");
                } else if (op >= 2) {
#pragma unroll
                    for (int ai = 0; ai < 2; ++ai)
#pragma unroll
                        for (int m = 0; m < 4; ++m) {
                            const int dr = ai * HALF + m * 16;
                            f32x4 v0 = acc[ai][bj][m][0], v1 = acc[ai][bj][m][1];
#pragma unroll
                            for (int e = 0; e < 4; ++e) {
                                const float s0 = rcpf_(1.f + ex2(-LOG2E * v0[e])), s1 = rcpf_(1.f + ex2(-LOG2E * v1[e]));
                                v0[e] = op == 2 ? v0[e] * s0 : s0; v1[e] = op == 2 ? v1[e] * s1 : s1;
                            }
                            u32x4 w; w.x = pk2(v0[0], v0[1]); w.y = pk2(v0[2], v0[3]); w.z = pk2(v1[0], v1[1]); w.w = pk2(v1[2], v1[3]);
                            __builtin_nontemporal_store(w, (u32x4*)(base + (size_t)dr * ld * 2 + voff));
                            asm volatile("" ::: "memory");
                        }
                } else {
                    const float sc = op == 1 ? C2 : 1.f;
#pragma unroll
                    for (int ai = 0; ai < 2; ++ai)
#pragma unroll
                        for (int m = 0; m < 4; ++m) {
                            const int dr = ai * HALF + m * 16;
                            const f32x4 v0 = acc[ai][bj][m][0] * sc, v1 = acc[ai][bj][m][1] * sc;
                            u32x4 w; w.x = pk2(v0[0], v0[1]); w.y = pk2(v0[2], v0[3]); w.z = pk2(v1[0], v1[1]); w.w = pk2(v1[2], v1[3]);
                            __builtin_nontemporal_store(w, (u32x4*)(base + (size_t)dr * ld * 2 + voff));
                            asm volatile("" ::: "memory");
                        }
                }
            }
        } else if constexpr (KIND == 3 || KIND == 4) {
            const int tid = (wr * 4 + wc) * 64 + fq * 16 + fr;
            const char* ib = (const char*)(xin + u.pn * BM) + (size_t)u.pm * BM * 4096; char* ob = (char*)(xout + u.pn * BM) + (size_t)u.pm * BM * 4096;
            const unsigned xoff = (unsigned)(rl * 1024 + cl) * 4u;
#define PKADD_INPLACE(A, X) do { f32x2_t lo_ = {(A)[0], (A)[1]}, hi_ = {(A)[2], (A)[3]}; const f32x2_t xl_ = {(X)[0], (X)[1]}, xh_ = {(X)[2], (X)[3]}; \
        asm volatile("v_pk_add_f32 %0, %0, %1" : "+v"(lo_) : "v"(xl_)); asm volatile("v_pk_add_f32 %0, %0, %1" : "+v"(hi_) : "v"(xh_)); (A) = (f32x4){lo_[0], lo_[1], hi_[0], hi_[1]}; } while (0)
            unsigned xo = xoff;
#pragma unroll
            for (int bj = 0; bj < 2; ++bj) {
                f32x4 x0[8], x1[8];
#pragma unroll
                for (int q = 0; q < 8; ++q) { const size_t uo = (size_t)((q >> 2) * HALF + (q & 3) * 16) * 4096 + bj * 512; x0[q] = __builtin_nontemporal_load((const f32x4*)(ib + uo + xo)); x1[q] = __builtin_nontemporal_load((const f32x4*)(ib + uo + xo + 16)); }
#pragma unroll
                for (int q = 0; q < 8; ++q) { PKADD_INPLACE(acc[q >> 2][bj][q & 3][0], x0[q]); PKADD_INPLACE(acc[q >> 2][bj][q & 3][1], x1[q]); }
                asm volatile("" : "+v"(xo));
            }
            LAS float* P = (LAS float*)xl;
            LAS float* Sr = (LAS float*)(xl + 4096);
#pragma unroll
            for (int ai = 0; ai < 2; ++ai)
#pragma unroll
                for (int m = 0; m < 4; ++m) {
                    float sq = 0.f;
#pragma unroll
                    for (int bj = 0; bj < 2; ++bj)
#pragma unroll
                        for (int n = 0; n < 2; ++n) { const f32x4 v = acc[ai][bj][m][n]; sq += (v[0] * v[0] + v[1] * v[1]) + (v[2] * v[2] + v[3] * v[3]); }
                    sq += bperm(sq, (fq * 16 + fr) ^ 16); sq += bperm(sq, (fq * 16 + fr) ^ 32);
                    if (fq == 0) P[(ai * HALF + rl + m * 16) * 4 + wc] = sq;
                }
            asm volatile("s_waitcnt lgkmcnt(0)" ::: "memory"); __builtin_amdgcn_s_barrier(); asm volatile("" ::: "memory");
            if (tid < 256) {
                const f32x4 p4 = *(LAS const f32x4*)(P + tid * 4);
                __hip_atomic_store(slots + ((size_t)(u.pm * BM + tid) * 4 + u.pn), __float_as_uint((p4[0] + p4[1]) + (p4[2] + p4[3])), __ATOMIC_RELAXED, __HIP_MEMORY_SCOPE_AGENT);
            }
            asm volatile("s_waitcnt vmcnt(0)" ::: "memory"); __builtin_amdgcn_s_barrier(); asm volatile("" ::: "memory");
            if (tid == 0) {
                __hip_atomic_fetch_add(cnt + 64 * u.pm, 1u, __ATOMIC_RELAXED, __HIP_MEMORY_SCOPE_AGENT);
                unsigned sp = 0;
                while (__hip_atomic_load(cnt + 64 * u.pm, __ATOMIC_RELAXED, __HIP_MEMORY_SCOPE_AGENT) < 4u) { __builtin_amdgcn_s_sleep(2); if (++sp > (1u << 17)) break; }
                __builtin_amdgcn_fence(__ATOMIC_ACQUIRE, "agent");
            }
            asm volatile("s_waitcnt vmcnt(0) lgkmcnt(0)" ::: "memory"); __builtin_amdgcn_s_barrier(); asm volatile("" ::: "memory");
            if (tid < 256) {
                const unsigned* sl = slots + (size_t)(u.pm * BM + tid) * 4; float ss = 0.f;
#pragma unroll
                for (int t4 = 0; t4 < 4; ++t4) ss += __uint_as_float(__hip_atomic_load(sl + t4, __ATOMIC_RELAXED, __HIP_MEMORY_SCOPE_AGENT));
                Sr[tid] = 1.0f / sqrtf(ss * (1.f / 1024.f) + RMS_EPS);
            }
            asm volatile("s_waitcnt lgkmcnt(0)" ::: "memory"); __builtin_amdgcn_s_barrier(); asm volatile("" ::: "memory");
#pragma unroll
            for (int bj = 0; bj < 2; ++bj) {
                const f32x4 g0 = *(const f32x4*)(gfin + u.pn * BM + bj * HALF + cl), g1 = *(const f32x4*)(gfin + u.pn * BM + bj * HALF + cl + 4);
#pragma unroll
                for (int q = 0; q < 8; ++q) { const size_t uo = (size_t)((q >> 2) * HALF + (q & 3) * 16) * 4096 + bj * 512; const float rs = Sr[(q >> 2) * HALF + rl + (q & 3) * 16];
                    const f32x4 h0 = acc[q >> 2][bj][q & 3][0] * rs * g0, h1 = acc[q >> 2][bj][q & 3][1] * rs * g1;
                    if constexpr (KIND == 3) { __builtin_nontemporal_store(h0, (f32x4*)(ob + uo + xoff)); __builtin_nontemporal_store(h1, (f32x4*)(ob + uo + xoff + 16)); }
                    else { __builtin_nontemporal_store(acc[q >> 2][bj][q & 3][0], (f32x4*)(ob + uo + xoff)); __builtin_nontemporal_store(acc[q >> 2][bj][q & 3][1], (f32x4*)(ob + uo + xoff + 16));
                        u32x4 w; w.x = pk2(h0[0], h0[1]); w.y = pk2(h0[2], h0[3]); w.z = pk2(h1[0], h1[1]); w.w = pk2(h1[2], h1[3]);
                        *(u32x4*)((char*)(Hout + u.pn * BM) + (size_t)u.pm * BM * 2048 + (uo >> 1) + (xoff >> 1)) = w; } }
                asm volatile("" ::: "memory");
            }
            asm volatile("s_waitcnt lgkmcnt(0)" ::: "memory"); __builtin_amdgcn_s_barrier(); asm volatile("" ::: "memory");
        } else if constexpr (KIND == 2) {
            const char* ib = (const char*)(xin + u.pn * BM) + (size_t)u.pm * BM * 4096; char* ob = (char*)(xout + u.pn * BM) + (size_t)u.pm * BM * 4096;
            const unsigned xoff = (unsigned)(rl * 1024 + cl) * 4u;
#pragma unroll
            for (int bj = 0; bj < 2; ++bj) {
                f32x4 x0[8], x1[8];
#pragma unroll
                for (int q = 0; q < 8; ++q) { const size_t uo = (size_t)((q >> 2) * HALF + (q & 3) * 16) * 4096 + bj * 512; x0[q] = *(const f32x4*)(ib + uo + xoff); x1[q] = *(const f32x4*)(ib + uo + xoff + 16); }
                asm volatile("" ::: "memory");
#pragma unroll
                for (int q = 0; q < 8; ++q) { const size_t uo = (size_t)((q >> 2) * HALF + (q & 3) * 16) * 4096 + bj * 512;
                    *(f32x4*)(ob + uo + xoff) = x0[q] + acc[q >> 2][bj][q & 3][0]; *(f32x4*)(ob + uo + xoff + 16) = x1[q] + acc[q >> 2][bj][q & 3][1]; }
                asm volatile("" ::: "memory");
            }
        }
#pragma unroll
        for (int bj = 0; bj < 2; ++bj)
#pragma unroll
            for (int ai = 0; ai < 2; ++ai)
#pragma unroll
                for (int m = 0; m < 4; ++m) { acc[ai][bj][m][0] = (f32x4){0.f, 0.f, 0.f, 0.f}; acc[ai][bj][m][1] = (f32x4){0.f, 0.f, 0.f, 0.f}; }
    }
};

template <int KIND> __device__ __forceinline__ void gemm_phase(LAS unsigned char* lds, const bf16_t* A, const bf16_t* Bt, const Sched& S, const Epi& E) {
    int tid_ = threadIdx.x; asm volatile("" : "+v"(tid_));
    const int tid = tid_, wid = __builtin_amdgcn_readfirstlane(tid >> 6), lane = tid & 63, wr = wid >> 2, wc = wid & 3, fr = lane & 15, fq = lane >> 4;
    unsigned voffA[2], voffB[2];
#pragma unroll
    for (int i = 0; i < 2; ++i) { int R, C; stage_rc(tid * 16 + i * 8192, R, C); const int Rb = (R & ~31) + perm32(R & 31);
        voffA[i] = (unsigned)(R * LD + C) * 2u; voffB[i] = (unsigned)(Rb * LD + C) * 2u; }
    const size_t kstep = (size_t)(BK * 2);
    const size_t hstep = (size_t)HALF * LD * 2;
    const size_t tstep = 2 * hstep;
    const unsigned ldsw = (unsigned)wid * 1024u;
    const int aoff = lds_byte(wr * 64 + fr, fq * 8), boff = lds_byte(wc * 32 + fr, fq * 8);
#define PG8_SA(b, h) (((b) * 2 + (h)) * HTB)
#define PG8_SB(b, h) ((4 + (b) * 2 + (h)) * HTB)
#define PG8_STAGE(bufoff, gbase, voff) do { _Pragma("unroll") for (int _i = 0; _i < 2; ++_i) \
        __builtin_amdgcn_global_load_lds((const unsigned*)((const char*)(gbase) + (voff)[_i]), (LAS unsigned*)(lds + (bufoff) + ldsw + _i * 8192), 16, 0, 0); } while (0)
#define PG8_LDA(dst, b, h) do { _Pragma("unroll") for (int m = 0; m < 4; ++m) _Pragma("unroll") for (int k = 0; k < 2; ++k) dst[m][k] = *(const LAS bf16x8*)(lds + PG8_SA(b, h) + aoff + m * 2048 + k * 1024); } while (0)
#define PG8_LDB(dst, b, h) do { _Pragma("unroll") for (int n = 0; n < 2; ++n) _Pragma("unroll") for (int k = 0; k < 2; ++k) dst[n][k] = *(const LAS bf16x8*)(lds + PG8_SB(b, h) + boff + n * 2048 + k * 1024); } while (0)
#define PG8_MMA(ai, bj, At, Bt_) do { __builtin_amdgcn_s_setprio(1); _Pragma("unroll") for (int m = 0; m < 4; ++m) _Pragma("unroll") for (int n = 0; n < 2; ++n) _Pragma("unroll") for (int k = 0; k < 2; ++k) \
        acc[ai][bj][m][n] = __builtin_amdgcn_mfma_f32_16x16x32_bf16(Bt_[n][k], At[m][k], acc[ai][bj][m][n], 0, 0, 0); __builtin_amdgcn_s_setprio(0); } while (0)
#define PG8_WAIT_V(n) asm volatile("s_waitcnt vmcnt(" #n ")" ::: "memory")
#define PG8_WAIT_L(n) asm volatile("s_waitcnt lgkmcnt(" #n ")" ::: "memory")
#define PG8_BAR __builtin_amdgcn_s_barrier()
#define PG8_SCHED __builtin_amdgcn_sched_barrier(0)
    Unit cur, nxt; int ui = 0;
    if (!S.next(0, cur)) return;
    f32x4 acc[2][2][4][2];
#pragma unroll
    for (int a = 0; a < 2; ++a)
#pragma unroll
        for (int b = 0; b < 2; ++b)
#pragma unroll
            for (int m = 0; m < 4; ++m)
#pragma unroll
                for (int n = 0; n < 2; ++n) acc[a][b][m][n] = (f32x4){0.f, 0.f, 0.f, 0.f};
    bf16x8 At[4][2], B0[2][2], B1[2][2];
    const char* cA = (const char*)A + (size_t)cur.pm * tstep + (size_t)cur.k0 * 2; const char* cB = (const char*)Bt + (size_t)cur.pn * tstep + (size_t)cur.k0 * 2;
    PG8_STAGE(PG8_SB(0, 0), cB, voffB); PG8_STAGE(PG8_SB(0, 1), cB + hstep, voffB); PG8_STAGE(PG8_SA(0, 0), cA, voffA); PG8_STAGE(PG8_SA(0, 1), cA + hstep, voffA);
    if (wr == 1) PG8_BAR;
    PG8_WAIT_V(2); PG8_BAR;
    PG8_STAGE(PG8_SB(1, 0), cB + kstep, voffB); PG8_STAGE(PG8_SA(1, 0), cA + kstep, voffA); PG8_STAGE(PG8_SB(1, 1), cB + hstep + kstep, voffB);
    PG8_WAIT_V(6); PG8_BAR;
    for (;;) {
        const bool has_next = S.next(ui + 1, nxt);
        const char* nA = has_next ? (const char*)A + (size_t)nxt.pm * tstep + (size_t)nxt.k0 * 2 : cA; const char* nB = has_next ? (const char*)Bt + (size_t)nxt.pn * tstep + (size_t)nxt.k0 * 2 : cB;
        const int nt = cur.nt;
        for (int t = 0; t < nt; t += 2) {
            const bool last = (t == nt - 2);
            const char* a1 = cA + (size_t)(t + 1) * kstep;
            const char* a2 = last ? nA : cA + (size_t)(t + 2) * kstep; const char* b2 = last ? nB : cB + (size_t)(t + 2) * kstep;
            const char* a3 = a2 + kstep; const char* b3 = b2 + kstep;
            PG8_LDB(B0, 0, 0); PG8_LDB(B1, 0, 1); PG8_SCHED; PG8_LDA(At, 0, 0); PG8_STAGE(PG8_SA(1, 1), a1 + hstep, voffA);
            PG8_WAIT_V(8); PG8_WAIT_L(0); PG8_BAR; PG8_MMA(0, 0, At, B0); PG8_MMA(0, 1, At, B1); PG8_BAR; PG8_SCHED;
            PG8_LDA(At, 0, 1); PG8_STAGE(PG8_SB(0, 0), b2, voffB); PG8_STAGE(PG8_SB(0, 1), b2 + hstep, voffB); PG8_STAGE(PG8_SA(0, 0), a2, voffA);
            PG8_WAIT_V(8); PG8_WAIT_L(0); PG8_BAR; PG8_MMA(1, 0, At, B0); PG8_MMA(1, 1, At, B1); PG8_BAR; PG8_SCHED;
            PG8_LDB(B0, 1, 0); PG8_LDB(B1, 1, 1); PG8_SCHED; PG8_LDA(At, 1, 0); PG8_STAGE(PG8_SA(0, 1), a2 + hstep, voffA);
            PG8_WAIT_V(8); PG8_WAIT_L(0); PG8_BAR; PG8_MMA(0, 0, At, B0); PG8_MMA(0, 1, At, B1); PG8_BAR; PG8_SCHED;
            PG8_LDA(At, 1, 1); PG8_STAGE(PG8_SB(1, 0), b3, voffB); PG8_STAGE(PG8_SB(1, 1), b3 + hstep, voffB); PG8_STAGE(PG8_SA(1, 0), a3, voffA);
            PG8_WAIT_V(8); PG8_WAIT_L(0); PG8_BAR; PG8_MMA(1, 0, At, B0); PG8_MMA(1, 1, At, B1); PG8_BAR; PG8_SCHED;
        }
        if (wr == 0) PG8_BAR;
        E.template run<KIND>(acc, cur, wr, wc, fr, fq);
        if (!has_next) break;
        cur = nxt; cA = nA; cB = nB; ++ui;
        if (wr == 1) PG8_BAR;
    }
    PG8_WAIT_V(0);
    PG8_BAR;
#undef PG8_SA
#undef PG8_SB
#undef PG8_STAGE
#undef PG8_LDA
#undef PG8_LDB
#undef PG8_MMA
#undef PG8_WAIT_V
#undef PG8_WAIT_L
#undef PG8_BAR
#undef PG8_SCHED
}
}

struct Args {
    const float* x; const float* norm_g; const float* w_in; const float* b_forget; const float* sinks;
    const float* w_br_a; const float* w_br_b; const float* w_br_c; const float* w_out; const float* final_g;
    float* out; unsigned char* ws;
    float inv_freq[32];
};

__device__ __forceinline__ float wave_sum(float v, int lane) {
#pragma unroll
    for (int o = 1; o < 64; o <<= 1) v += bperm(v, lane ^ o);
    return v;
}
__device__ __forceinline__ int orig_col(int np) {
    if (np < 768) return np;
    const bool rope = (np >= 1024 && np < 1792) || (np >= 2560 && np < 3072);
    if (!rope) return np + 4;
    const int p = np & 63, base = np - p;
    return base + (p >> 1) + 32 * (p & 1) + 4;
}
__device__ __forceinline__ void transpose_item(const float* W, int ldw, bool permute, bf16_t* WT, int ldt, int kdst, LAS float* scr, int k0, int n0, int lane) {
    const int nn = n0 + (lane & 31), sc = permute ? orig_col(nn) : nn;
#pragma unroll 8
    for (int i = 0; i < 32; ++i) { const int kk = 2 * i + (lane >> 5); scr[kk * 33 + (lane & 31)] = __builtin_nontemporal_load(W + (size_t)(k0 + kk) * ldw + sc); }
    asm volatile("s_waitcnt lgkmcnt(0)" ::: "memory");
    const int c = lane & 7;
#pragma unroll
    for (int j = 0; j < 4; ++j) { const int n = (lane >> 3) + 8 * j; const LAS float* s = scr + (8 * c) * 33 + n;
        u32x4 o; o.x = pk2(s[0 * 33], s[1 * 33]); o.y = pk2(s[2 * 33], s[3 * 33]); o.z = pk2(s[4 * 33], s[5 * 33]); o.w = pk2(s[6 * 33], s[7 * 33]);
        *(u32x4*)(WT + (size_t)(n0 + n) * ldt + kdst + k0 + 8 * c) = o; }
    asm volatile("s_waitcnt lgkmcnt(0)" ::: "memory");
}

__device__ __forceinline__ void prep_phase(const Args& a, int layer, LAS unsigned char* lds, int vcu, int G) {
    int tid_ = threadIdx.x; asm volatile("" : "+v"(tid_));
    const int tid = tid_, lane = tid & 63, wave = __builtin_amdgcn_readfirstlane(tid >> 6);
    LAS float* scr = (LAS float*)(lds + wave * 16384);
    const int gw = vcu * 8 + wave, NGW = G * 8;
    unsigned char* ws = a.ws;
    const float* w_in = a.w_in + (size_t)layer * D * NIN;
    constexpr int I_IN = 16 * (NP / 32), I_A = 4 * 32, I_B = 6 * 32, I_C = 6 * 32, I_O = 16 * 32;
    constexpr int NITEMS = I_IN + I_A + I_B + I_C + I_O;
    for (int it = gw; it < NITEMS; it += NGW) {
        int r = it;
        if (r < I_IN) { const int nb = r % (NP / 32), kb = r / (NP / 32); transpose_item(w_in, NIN, true, (bf16_t*)(ws + WS_WIN), 1024, 0, scr, 64 * kb, 32 * nb, lane); continue; } r -= I_IN;
        if (r < I_A) { transpose_item(a.w_br_a + (size_t)layer * 256 * 1024, 1024, false, (bf16_t*)(ws + WS_WBR), 1024, 0, scr, 64 * (r / 32), 32 * (r % 32), lane); continue; } r -= I_A;
        if (r < I_B) { transpose_item(a.w_br_b + (size_t)layer * 384 * 1024, 1024, false, (bf16_t*)(ws + WS_WBR), 1024, 256, scr, 64 * (r / 32), 32 * (r % 32), lane); continue; } r -= I_B;
        if (r < I_C) { transpose_item(a.w_br_c + (size_t)layer * 384 * 1024, 1024, false, (bf16_t*)(ws + WS_WBR), 1024, 640, scr, 64 * (r / 32), 32 * (r % 32), lane); continue; } r -= I_C;
        transpose_item(a.w_out + (size_t)layer * 1024 * 1024, 1024, false, (bf16_t*)(ws + WS_WOUT), 1024, 0, scr, 64 * (r / 32), 32 * (r % 32), lane);
    }
    if (layer == 0) {
        float* cosT = (float*)(ws + WS_COS); float* sinT = (float*)(ws + WS_SIN);
        for (int e = vcu * NTHREADS + tid; e < SEQ * 32; e += G * NTHREADS) {
            const int pos = e >> 5, i = e & 31;
            const float angf = (float)pos * a.inv_freq[i];
            const double ang = (double)angf;
            const double n = __builtin_rint(ang * 0.15915494309189535);
            double r = ang - n * 6.283185307179586232; r -= n * 2.449293598294706414e-16;
            const double r2 = r * r;
            double cs = 1.0, sn = 1.0;
            double cc = 0.0, ss = 0.0;
#pragma unroll
            for (int k = 13; k >= 1; --k) { cc = (cc + 1.0) * (-r2 / (double)((2 * k - 1) * (2 * k))); ss = (ss + 1.0) * (-r2 / (double)((2 * k) * (2 * k + 1))); }
            cs = 1.0 + cc; sn = r * (1.0 + ss);
            cosT[e] = (float)cs; sinT[e] = (float)sn;
        }
    }
    const float* xin = layer == 0 ? a.x : a.out;
    const float* g = a.norm_g + layer * D;
    f32x4 gv[4], wf[16];
#pragma unroll
    for (int j = 0; j < 4; ++j) gv[j] = *(const f32x4*)(g + 256 * j + 4 * lane);
#pragma unroll
    for (int j = 0; j < 4; ++j)
#pragma unroll
        for (int e = 0; e < 4; ++e) wf[4 * j + e] = *(const f32x4*)(w_in + (size_t)(256 * j + 4 * lane + e) * NIN + 768);
    const f32x4 bfv = *(const f32x4*)(a.b_forget + 4 * layer);
    bf16_t* H = (bf16_t*)(ws + WS_H); float* logf = (float*)(ws + WS_LOGF);
    if (layer > 0) {
        for (int m = gw; m < M; m += NGW) {
            const u32x2* hr = (const u32x2*)(H + (size_t)m * D) + lane;
            f32x4 fa = (f32x4){0.f, 0.f, 0.f, 0.f};
#pragma unroll
            for (int j = 0; j < 4; ++j) { const u32x2 hw = hr[64 * j];
                fa += wf[4 * j + 0] * bflo(hw.x); fa += wf[4 * j + 1] * bfhi(hw.x); fa += wf[4 * j + 2] * bflo(hw.y); fa += wf[4 * j + 3] * bfhi(hw.y); }
            fa.x = wave_sum(fa.x, lane); fa.y = wave_sum(fa.y, lane); fa.z = wave_sum(fa.z, lane); fa.w = wave_sum(fa.w, lane);
            if (lane == 0) {
                f32x4 o;
#pragma unroll
                for (int e = 0; e < 4; ++e) { const float t = fa[e] + bfv[e]; o[e] = fminf(t, 0.f) - log1pf(expf(-fabsf(t))); }
                *(f32x4*)(logf + (size_t)m * 4) = o;
            }
        }
        return;
    }
    for (int m = gw; m < M; m += NGW) {
        const f32x4* xr = (const f32x4*)(xin + (size_t)m * D) + lane;
        f32x4 v[4]; float s2 = 0.f;
#pragma unroll
        for (int j = 0; j < 4; ++j) { v[j] = __builtin_nontemporal_load(xr + 64 * j); s2 += (v[j].x * v[j].x + v[j].y * v[j].y) + (v[j].z * v[j].z + v[j].w * v[j].w); }
        const float rs = 1.0f / sqrtf(wave_sum(s2, lane) * (1.f / D) + RMS_EPS);
        f32x4 fa = (f32x4){0.f, 0.f, 0.f, 0.f};
        unsigned long long* o8 = (unsigned long long*)(H + (size_t)m * D) + lane;
#pragma unroll
        for (int j = 0; j < 4; ++j) {
            const f32x4 h = v[j] * rs * gv[j];
            fa += wf[4 * j + 0] * h.x; fa += wf[4 * j + 1] * h.y; fa += wf[4 * j + 2] * h.z; fa += wf[4 * j + 3] * h.w;
            o8[64 * j] = (unsigned long long)pk2(h.x, h.y) | ((unsigned long long)pk2(h.z, h.w) << 32);
        }
        fa.x = wave_sum(fa.x, lane); fa.y = wave_sum(fa.y, lane); fa.z = wave_sum(fa.z, lane); fa.w = wave_sum(fa.w, lane);
        if (lane == 0) {
            f32x4 o;
#pragma unroll
            for (int e = 0; e < 4; ++e) { const float t = fa[e] + bfv[e]; o[e] = fminf(t, 0.f) - log1pf(expf(-fabsf(t))); }
            *(f32x4*)(logf + (size_t)m * 4) = o;
        }
    }
}

__device__ __forceinline__ void cumsum_phase(const Args& a, int blk) {
    if (blk >= 8) return;
    int tid_ = threadIdx.x; asm volatile("" : "+v"(tid_));
    const int tid = tid_, lane = tid & 63, w = tid >> 6, seq = blk * 8 + w, b = seq >> 2, h = seq & 3;
    const float* lf = (const float*)(a.ws + WS_LOGF) + ((size_t)b * SEQ + 32 * lane) * 4 + h;
    float* cb = (float*)(a.ws + WS_CB) + (size_t)(b * 4 + h) * SEQ + 32 * lane;
    float v[32]; float run = 0.f;
#pragma unroll
    for (int i = 0; i < 32; ++i) { run += lf[4 * i]; v[i] = run; }
    float x = run;
#pragma unroll
    for (int o = 1; o < 64; o <<= 1) { const float t = bperm(x, lane >= o ? lane - o : lane); if (lane >= o) x += t; }
    const float excl = x - run;
#pragma unroll
    for (int i = 0; i < 32; i += 4) { f32x4 o4; o4.x = -LOG2E * (excl + v[i]); o4.y = -LOG2E * (excl + v[i + 1]); o4.z = -LOG2E * (excl + v[i + 2]); o4.w = -LOG2E * (excl + v[i + 3]); *(f32x4*)(cb + i) = o4; }
}

namespace attn {
constexpr int KPL = 2064;
constexpr int VPL = 8256;
constexpr int OFF_V = 8 * KPL;
constexpr int OFF_B = OFF_V + 2 * VPL;
constexpr int BUF = OFF_B + 512;
constexpr int NBUF = 3;
constexpr int OFF_WS = NBUF * BUF;
constexpr int OFF_ST = OFF_WS + 8 * 256;
constexpr int ST_BYTES = 32 * 144;
static_assert(OFF_ST + 8 * ST_BYTES <= LDS_BYTES - 256, "attention LDS map");

struct Item { int valid, type, b, h, qcol, kcol, vcol, zcol, ycol, dil, res0, M0, c0, c1, W; };

__device__ __forceinline__ Item make_item(int sub, int g, int j) {
    Item it; it.valid = 0; it.type = 0; it.b = 0; it.h = 0; it.qcol = 0; it.kcol = 0; it.vcol = 0; it.zcol = 0; it.ycol = 0; it.dil = 1; it.res0 = 0; it.M0 = 0; it.c0 = 0; it.c1 = 1; it.W = 128;
    if (sub == 0) {
        if (j >= 8) return it;
        it.valid = 1;
        if (j < 2) {
            const int bh = g >> 2, s = g & 3, qb = j == 0 ? s : 7 - s, h = bh & 3;
            it.type = 0; it.b = bh >> 2; it.h = h; it.qcol = 64 * h; it.kcol = h; it.vcol = 12 + h; it.zcol = 256 + 64 * h; it.ycol = 64 * h;
            it.M0 = 256 * qb; it.c0 = 0; it.c1 = 2 * (qb + 1); it.W = 1 << 30; return it;
        }
        const bool isC = j >= 5; const int idx = g * 3 + (j - (isC ? 5 : 2)), b = idx / 48, rem = idx % 48, h = rem >> 3, blk = rem & 7;
        it.b = b; it.h = h; it.M0 = 256 * blk; it.c0 = blk == 0 ? 1 : 0; it.c1 = 3;
        const int kvh = h / 3;
        it.type = isC ? 4 : 1; it.qcol = (isC ? 1280 : 512) + 64 * h; it.kcol = isC ? 10 + kvh : 4 + h; it.vcol = isC ? 22 + kvh : 16 + h;
        it.zcol = (isC ? 1664 : 896) + 64 * h; it.ycol = (isC ? 640 : 256) + 64 * h; it.W = isC ? 127 : 128;
        return it;
    }
    if (j >= 3) return it;
    it.valid = 1;
    const int idx = g * 3 + j, b = idx / 48, rem = idx % 48, h = rem >> 3, r8 = rem & 7;
    it.b = b; it.h = h; it.qcol = 512 + 64 * h; it.kcol = 4 + h; it.vcol = 16 + h; it.zcol = 896 + 64 * h; it.ycol = 256 + 64 * h; it.W = 128;
    const int blk = r8 & 1;
    it.type = sub == 1 ? 2 : 3; it.dil = sub == 1 ? 4 : 16; it.res0 = sub == 1 ? (r8 >> 1) : 2 * r8; it.M0 = sub == 1 ? 256 * blk : 0; it.c0 = (sub == 1 && blk == 0) ? 1 : 0; it.c1 = sub == 1 ? 3 : 2;
    return it;
}
__device__ __forceinline__ void chunk_src(const Item& it, int c, int& kp0, int& kres) {
    if (it.type == 0) { kp0 = 128 * c; kres = 0; }
    else if (it.type == 3) { kp0 = 0; kres = it.res0 + c; }
    else { kp0 = it.M0 - 128 + 128 * c; kres = it.res0; }
}
__device__ __forceinline__ s16x4 vtr(LAS const unsigned char* p) {
    typedef short v4i16_t __attribute__((ext_vector_type(4)));
    return __builtin_bit_cast(s16x4, __builtin_amdgcn_ds_read_tr16_b64_v4i16((LAS v4i16_t*)p));
}

__device__ __forceinline__ void attn_phase(const Args& a, int layer, int sub, LAS unsigned char* lds, int g) {
    int tid_ = threadIdx.x; asm volatile("" : "+v"(tid_));
    const int tid = tid_, lane = tid & 63, w = __builtin_amdgcn_readfirstlane(tid >> 6), hi = lane >> 5, l31 = lane & 31;
    const bf16_t* QKVZ = (const bf16_t*)(a.ws + WS_QKVZ); const bf16_t* KVH = (const bf16_t*)(a.ws + WS_QKVZ + KVH_OFF); bf16_t* Y = (bf16_t*)(a.ws + WS_H); float* LSE = (float*)(a.ws + WS_LSE); const float* CB = (const float*)(a.ws + WS_CB);
    LAS float* wsf = (LAS float*)(lds + OFF_WS + w * 256);
    LAS bf16_t* stg = (LAS bf16_t*)(lds + OFF_ST + w * ST_BYTES);
    int j = 0, cb;
    { const Item it0 = make_item(sub, g, 0); if (!it0.valid) return; cb = it0.c0; }
    u32x4 kreg[NBUF][2], vreg[NBUF][2]; float breg[NBUF]; bf16x8 qn[4];
#define ATT_ISSUE(IT, CBEG, NCH) do { _Pragma("unroll") for (int ci_ = 0; ci_ < NBUF; ++ci_) if (ci_ < (NCH)) { int kp0_, kres_; chunk_src(IT, (CBEG) + ci_, kp0_, kres_); \
        _Pragma("unroll") for (int i_ = 0; i_ < 2; ++i_) { const int p_ = tid + 512 * i_, key_ = p_ >> 3, c16_ = p_ & 7; int m_ = kp0_ + key_; m_ = m_ < 0 ? 0 : m_; \
            const size_t ro_ = (size_t)((IT).b * SEQ + m_ * (IT).dil + kres_) * 64 + c16_ * 8; \
            kreg[ci_][i_] = *(const u32x4*)(KVH + (size_t)(IT).kcol * (NBATCH * SEQ * 64) + ro_); vreg[ci_][i_] = *(const u32x4*)(KVH + (size_t)(IT).vcol * (NBATCH * SEQ * 64) + ro_); } \
        breg[ci_] = CB[(size_t)((IT).b * 4 + ((IT).h & 3)) * SEQ + ((kp0_ + (tid & 127)) & (SEQ - 1))]; } \
        if ((CBEG) == (IT).c0) { const int qres_ = (IT).type == 3 ? (IT).res0 + (w >> 2) : (IT).res0, mq0_ = (IT).type == 3 ? 32 * (w & 3) : (IT).M0 + 32 * w; \
            const bf16_t* qp_ = QKVZ + (size_t)((IT).b * SEQ + (mq0_ + l31) * (IT).dil + qres_) * NQ + (IT).qcol + 8 * hi; \
            _Pragma("unroll") for (int s_ = 0; s_ < 4; ++s_) qn[s_] = *(const bf16x8*)(qp_ + 16 * s_); } } while (0)
    { const Item it0 = make_item(sub, g, 0); const int n0 = it0.c1 - cb < NBUF ? it0.c1 - cb : NBUF; ATT_ISSUE(it0, cb, n0); }
    bf16x8 qf[4]; f32x16 o0, o1; float mrun = -1e30f, lrun = 0.f;
    for (;;) {
        const Item it = make_item(sub, g, j);
        const int nch = it.c1 - cb < NBUF ? it.c1 - cb : NBUF;
        int ncb = cb + nch, nj = j;
        if (ncb >= it.c1) nj = j + 1;
        const Item nx = make_item(sub, g, nj);
        const bool has_next = nx.valid != 0;
        if (nj != j) ncb = nx.c0;
        const int nnch = nx.c1 - ncb < NBUF ? nx.c1 - ncb : NBUF;
        __syncthreads();
#pragma unroll
        for (int ci = 0; ci < NBUF; ++ci) if (ci < nch) {
            LAS unsigned char* wb = lds + ci * BUF;
#pragma unroll
            for (int i = 0; i < 2; ++i) { const int p = tid + 512 * i, key = p >> 3, c16 = p & 7;
                *(LAS u32x4*)(wb + c16 * KPL + key * 16) = kreg[ci][i];
                *(LAS u32x4*)(wb + OFF_V + (c16 >> 2) * VPL + (key >> 3) * 512 + (key & 7) * 64 + (c16 & 3) * 16) = vreg[ci][i]; }
            if (tid < 128) *(LAS float*)(wb + OFF_B + tid * 4) = breg[ci];
        }
        __syncthreads();
        const int qres = it.type == 3 ? it.res0 + (w >> 2) : it.res0;
        const int mq0 = it.type == 3 ? 32 * (w & 3) : it.M0 + 32 * w;
        if (cb == it.c0) {
#pragma unroll
            for (int s = 0; s < 4; ++s) qf[s] = qn[s];
        }
        if (has_next) ATT_ISSUE(nx, ncb, nnch);
        if (cb == it.c0) {
#pragma unroll
            for (int r = 0; r < 16; ++r) { o0[r] = 0.f; o1[r] = 0.f; }
            mrun = -1e30f; lrun = 0.f;
        }
#pragma unroll 1
        for (int ci = 0; ci < nch; ++ci) {
        const int c = cb + ci;
        LAS unsigned char* buf = lds + ci * BUF;
        int kp0, kres; chunk_src(it, c, kp0, kres);
        if (kres == qres) {
#pragma unroll 1
            for (int jp = 0; jp < 2; ++jp) {
                const int a0 = kp0 + 64 * jp;
                if (a0 > mq0 + 31 || a0 + 63 < mq0 - it.W || a0 + 63 < 0) continue;
                const bool needmask = !(a0 + 63 <= mq0 && a0 >= mq0 + 31 - it.W && a0 >= 0);
                LAS const unsigned char* kb = buf + hi * KPL + (64 * jp + l31) * 16;
                const bf16x8 kf0 = *(LAS const bf16x8*)(kb), kf1 = *(LAS const bf16x8*)(kb + 2 * KPL), kf2 = *(LAS const bf16x8*)(kb + 4 * KPL), kf3 = *(LAS const bf16x8*)(kb + 6 * KPL);
                const bf16x8 kg0 = *(LAS const bf16x8*)(kb + 512), kg1 = *(LAS const bf16x8*)(kb + 512 + 2 * KPL), kg2 = *(LAS const bf16x8*)(kb + 512 + 4 * KPL), kg3 = *(LAS const bf16x8*)(kb + 512 + 6 * KPL);
                f32x16 s, t;
                if (it.type == 0) {
#pragma unroll
                    for (int g4 = 0; g4 < 4; ++g4) { const f32x4 bv = *(LAS const f32x4*)(buf + OFF_B + (64 * jp + 8 * g4 + 4 * hi) * 4), bw = *(LAS const f32x4*)(buf + OFF_B + (64 * jp + 32 + 8 * g4 + 4 * hi) * 4);
                        s[4 * g4] = bv.x; s[4 * g4 + 1] = bv.y; s[4 * g4 + 2] = bv.z; s[4 * g4 + 3] = bv.w; t[4 * g4] = bw.x; t[4 * g4 + 1] = bw.y; t[4 * g4 + 2] = bw.z; t[4 * g4 + 3] = bw.w; }
                    s = __builtin_amdgcn_mfma_f32_32x32x16_bf16(kf0, qf[0], s, 0, 0, 0);
                    t = __builtin_amdgcn_mfma_f32_32x32x16_bf16(kg0, qf[0], t, 0, 0, 0);
                } else {
                    const f32x16 z16 = {0.f, 0.f, 0.f, 0.f, 0.f, 0.f, 0.f, 0.f, 0.f, 0.f, 0.f, 0.f, 0.f, 0.f, 0.f, 0.f};
                    s = __builtin_amdgcn_mfma_f32_32x32x16_bf16(kf0, qf[0], z16, 0, 0, 0);
                    t = __builtin_amdgcn_mfma_f32_32x32x16_bf16(kg0, qf[0], z16, 0, 0, 0);
                }
                s = __builtin_amdgcn_mfma_f32_32x32x16_bf16(kf1, qf[1], s, 0, 0, 0);
                t = __builtin_amdgcn_mfma_f32_32x32x16_bf16(kg1, qf[1], t, 0, 0, 0);
                s = __builtin_amdgcn_mfma_f32_32x32x16_bf16(kf2, qf[2], s, 0, 0, 0);
                t = __builtin_amdgcn_mfma_f32_32x32x16_bf16(kg2, qf[2], t, 0, 0, 0);
                s = __builtin_amdgcn_mfma_f32_32x32x16_bf16(kf3, qf[3], s, 0, 0, 0);
                t = __builtin_amdgcn_mfma_f32_32x32x16_bf16(kg3, qf[3], t, 0, 0, 0);
                LAS const unsigned char* vb = buf + OFF_V + (8 * jp) * 512 + (4 * hi + ((lane & 15) >> 2)) * 64 + ((lane >> 4) & 1) * 32 + (lane & 3) * 8;
#define ATT_VF(cc, ks) ({ const s16x4 lo_ = vtr(vb + (cc) * VPL + (2 * (ks)) * 512), hi_ = vtr(vb + (cc) * VPL + (2 * (ks) + 1) * 512); (bf16x8){lo_[0], lo_[1], lo_[2], lo_[3], hi_[0], hi_[1], hi_[2], hi_[3]}; })
                const bf16x8 v00 = ATT_VF(0, 0), v01 = ATT_VF(0, 1), v02 = ATT_VF(0, 2), v03 = ATT_VF(0, 3), v10 = ATT_VF(1, 0), v11 = ATT_VF(1, 1), v12 = ATT_VF(1, 2), v13 = ATT_VF(1, 3);
#undef ATT_VF
                if (needmask) {
                    const int qpos = mq0 + l31;
#pragma unroll
                    for (int r = 0; r < 16; ++r) { const int kpos = a0 + (r & 3) + 8 * (r >> 2) + 4 * hi; const bool ok = kpos >= 0 && kpos <= qpos && qpos - kpos <= it.W; s[r] = ok ? s[r] : -INFINITY;
                        const int kp2 = kpos + 32; const bool ok2 = kp2 >= 0 && kp2 <= qpos && qpos - kp2 <= it.W; t[r] = ok2 ? t[r] : -INFINITY; }
                }
                float mx = __builtin_fmaxf(__builtin_fmaxf(s[0], s[1]), t[0]), my = __builtin_fmaxf(__builtin_fmaxf(s[2], s[3]), t[1]);
                mx = __builtin_fmaxf(__builtin_fmaxf(mx, t[2]), t[3]);
#pragma unroll
                for (int r = 4; r < 16; r += 4) { mx = __builtin_fmaxf(__builtin_fmaxf(mx, s[r]), s[r + 1]); my = __builtin_fmaxf(__builtin_fmaxf(my, s[r + 2]), s[r + 3]); mx = __builtin_fmaxf(__builtin_fmaxf(mx, t[r]), t[r + 1]); my = __builtin_fmaxf(__builtin_fmaxf(my, t[r + 2]), t[r + 3]); }
                mx = __builtin_fmaxf(mx, my);
                { const auto rr = __builtin_amdgcn_permlane32_swap(__float_as_uint(mx), __float_as_uint(mx), false, false); mx = fmaxf(__uint_as_float(rr[0]), __uint_as_float(rr[1])); }
                const float mnew = fmaxf(mrun, mx);
                if (__any(mx > mrun + 16.0f)) {
                    const float alpha = ex2(mrun - mnew); lrun *= alpha; mrun = mnew;
                    if (hi == 0) wsf[l31] = alpha;
#pragma unroll
                    for (int g4 = 0; g4 < 4; ++g4) { const f32x4 av = *(LAS const f32x4*)(wsf + 8 * g4 + 4 * hi);
                        o0[4 * g4] *= av.x; o0[4 * g4 + 1] *= av.y; o0[4 * g4 + 2] *= av.z; o0[4 * g4 + 3] *= av.w;
                        o1[4 * g4] *= av.x; o1[4 * g4 + 1] *= av.y; o1[4 * g4 + 2] *= av.z; o1[4 * g4 + 3] *= av.w; }
                }
                float ps = 0.f, pt = 0.f;
#pragma unroll
                for (int r = 0; r < 16; ++r) { s[r] = ex2(s[r] - mrun); ps += s[r]; t[r] = ex2(t[r] - mrun); pt += t[r]; }
                lrun += ps + pt;
                u32x4 pw0, pw1, pw2, pw3;
                pw0.x = pk2(s[0], s[1]); pw0.y = pk2(s[2], s[3]); pw0.z = pk2(s[4], s[5]); pw0.w = pk2(s[6], s[7]);
                pw1.x = pk2(s[8], s[9]); pw1.y = pk2(s[10], s[11]); pw1.z = pk2(s[12], s[13]); pw1.w = pk2(s[14], s[15]);
                pw2.x = pk2(t[0], t[1]); pw2.y = pk2(t[2], t[3]); pw2.z = pk2(t[4], t[5]); pw2.w = pk2(t[6], t[7]);
                pw3.x = pk2(t[8], t[9]); pw3.y = pk2(t[10], t[11]); pw3.z = pk2(t[12], t[13]); pw3.w = pk2(t[14], t[15]);
                const bf16x8 pa0 = __builtin_bit_cast(bf16x8, pw0), pa1 = __builtin_bit_cast(bf16x8, pw1), pa2 = __builtin_bit_cast(bf16x8, pw2), pa3 = __builtin_bit_cast(bf16x8, pw3);
                o0 = __builtin_amdgcn_mfma_f32_32x32x16_bf16(pa0, v00, o0, 0, 0, 0);
                o1 = __builtin_amdgcn_mfma_f32_32x32x16_bf16(pa0, v10, o1, 0, 0, 0);
                o0 = __builtin_amdgcn_mfma_f32_32x32x16_bf16(pa1, v01, o0, 0, 0, 0);
                o1 = __builtin_amdgcn_mfma_f32_32x32x16_bf16(pa1, v11, o1, 0, 0, 0);
                o0 = __builtin_amdgcn_mfma_f32_32x32x16_bf16(pa2, v02, o0, 0, 0, 0);
                o1 = __builtin_amdgcn_mfma_f32_32x32x16_bf16(pa2, v12, o1, 0, 0, 0);
                o0 = __builtin_amdgcn_mfma_f32_32x32x16_bf16(pa3, v03, o0, 0, 0, 0);
                o1 = __builtin_amdgcn_mfma_f32_32x32x16_bf16(pa3, v13, o1, 0, 0, 0);
            }
        }
        }
        if (cb + nch == it.c1) {
            float lt; { const auto rr = __builtin_amdgcn_permlane32_swap(__float_as_uint(lrun), __float_as_uint(lrun), false, false); lt = __uint_as_float(rr[0]) + __uint_as_float(rr[1]); }
            float scale, L2 = 0.f;
            if (it.type == 4) { const float sink2 = a.sinks[layer * 6 + it.h] * LOG2E, mf = fmaxf(mrun, sink2), al = ex2(mrun - mf); scale = al / (lt * al + ex2(sink2 - mf)); }
            else { scale = 1.f / lt; L2 = mrun + log2f(lt); }
            if (hi == 0) { wsf[l31] = scale; wsf[32 + l31] = L2; }
#pragma unroll
            for (int g4 = 0; g4 < 4; ++g4) { const f32x4 av = *(LAS const f32x4*)(wsf + 8 * g4 + 4 * hi);
#pragma unroll
                for (int e = 0; e < 4; ++e) { const int r = 4 * g4 + e, row = 8 * g4 + 4 * hi + e;
                    stg[row * 72 + l31] = (bf16_t)f2bf(o0[r] * av[e]); stg[row * 72 + 32 + l31] = (bf16_t)f2bf(o1[r] * av[e]); } }
#pragma unroll
            for (int i = 0; i < 4; ++i) {
                const int row = i * 8 + (lane >> 3), ch = lane & 7;
                const u32x4 ov = *(LAS const u32x4*)(stg + row * 72 + ch * 8);
                const size_t tok = (size_t)(it.b * SEQ + (mq0 + row) * it.dil + qres);
                bf16_t* yp = Y + tok * 1024 + it.ycol + ch * 8;
                float f[8] = {bflo(ov.x), bfhi(ov.x), bflo(ov.y), bfhi(ov.y), bflo(ov.z), bfhi(ov.z), bflo(ov.w), bfhi(ov.w)};
                if (it.type == 1) { if (ch == 0) LSE[tok * 6 + it.h] = wsf[32 + row]; }
                if (it.type == 2 || it.type == 3) {
                    const u32x4 od = *(const u32x4*)yp; const float Lold = LSE[tok * 6 + it.h], Lnew = wsf[32 + row], Lm = fmaxf(Lold, Lnew);
                    float wo = ex2(Lold - Lm), wn = ex2(Lnew - Lm); const float sw = wo + wn, inv = 1.f / sw; wo *= inv; wn *= inv;
                    const float q[8] = {bflo(od.x), bfhi(od.x), bflo(od.y), bfhi(od.y), bflo(od.z), bfhi(od.z), bflo(od.w), bfhi(od.w)};
#pragma unroll
                    for (int e = 0; e < 8; ++e) f[e] = wo * q[e] + wn * f[e];
                    if (it.type == 2 && ch == 0) LSE[tok * 6 + it.h] = Lm + log2f(sw);
                }
                if (it.type == 0 || it.type >= 3) {
                    const u32x4 zv = *(const u32x4*)(QKVZ + tok * NQ + it.zcol + ch * 8);
                    const float z[8] = {bflo(zv.x), bfhi(zv.x), bflo(zv.y), bfhi(zv.y), bflo(zv.z), bfhi(zv.z), bflo(zv.w), bfhi(zv.w)};
#pragma unroll
                    for (int e = 0; e < 8; ++e) f[e] *= z[e];
                }
                u32x4 wv; wv.x = pk2(f[0], f[1]); wv.y = pk2(f[2], f[3]); wv.z = pk2(f[4], f[5]); wv.w = pk2(f[6], f[7]);
                *(u32x4*)yp = wv;
            }
        }
        if (!has_next) break;
        cb = ncb; j = nj;
    }
#undef ATT_ISSUE
}
}

__device__ __forceinline__ void final_norm_phase(const Args& a, int vcu, int G) {
    int tid_ = threadIdx.x; asm volatile("" : "+v"(tid_));
    const int tid = tid_, lane = tid & 63, wave = tid >> 6, gw = vcu * 8 + wave, NGW = G * 8;
    f32x4 gv[4];
#pragma unroll
    for (int j = 0; j < 4; ++j) gv[j] = *(const f32x4*)(a.final_g + 256 * j + 4 * lane);
    for (int m = gw; m < M; m += NGW) {
        f32x4* xr = (f32x4*)(a.out + (size_t)m * D) + lane;
        f32x4 v[4]; float s2 = 0.f;
#pragma unroll
        for (int j = 0; j < 4; ++j) { v[j] = xr[64 * j]; s2 += (v[j].x * v[j].x + v[j].y * v[j].y) + (v[j].z * v[j].z + v[j].w * v[j].w); }
        const float rs = 1.0f / sqrtf(wave_sum(s2, lane) * (1.f / D) + RMS_EPS);
#pragma unroll
        for (int j = 0; j < 4; ++j) xr[64 * j] = v[j] * rs * gv[j];
    }
}


#define XB_TMO      128
#define XB_XCNT(j)  (256  + 64 * (j))
#define XB_XSUB(j)  (1280 + 64 * (j))
#define XB_XGEN(j)  (2304 + 64 * (j))
#define XB_TOP      3328
#define XB_TOPGEN   3392
#define XCD_BAR_WORDS 3456
#define XB_SPIN_CAP (1u << 18)
__device__ __forceinline__ unsigned xb_ld(unsigned* p)              { return __hip_atomic_load(p, __ATOMIC_RELAXED, __HIP_MEMORY_SCOPE_AGENT); }
__device__ __forceinline__ unsigned xb_add(unsigned* p, unsigned v) { return __hip_atomic_fetch_add(p, v, __ATOMIC_RELAXED, __HIP_MEMORY_SCOPE_AGENT); }
__device__ __forceinline__ unsigned xb_xcc_id() { return (unsigned)__builtin_amdgcn_s_getreg((3 << 11) | 20) & 0xFu; }
#define XB_SPIN(cond, bar) do { unsigned _sp = 0; while (cond) { __builtin_amdgcn_s_sleep(1); \
    if ((++_sp & 255u) == 0u) { if (xb_ld(&(bar)[XB_TMO])) break; if (_sp > XB_SPIN_CAP) { atomicAdd(&(bar)[XB_TMO], 1u); break; } } } } while (0)
struct XcdBarrier { unsigned* bar; unsigned x; volatile LAS unsigned* st; };
__device__ __forceinline__ XcdBarrier xcd_barrier_post(unsigned* bar, volatile LAS unsigned* st) {
    XcdBarrier b; b.bar = bar; b.x = xb_xcc_id(); b.st = st;
    if (threadIdx.x == 0) (void)xb_add(&bar[XB_XCNT(b.x)], 1u);
    return b;
}
__device__ __forceinline__ void xcd_barrier_complete(unsigned* bar, unsigned x, unsigned& nloc, unsigned& nx) {
    const unsigned G = gridDim.x * gridDim.y * gridDim.z;
    unsigned sum, cnt, mine, sp = 0u;
    for (;;) {
        sum = 0u; cnt = 0u; mine = 0u;
#pragma unroll
        for (unsigned j = 0; j < 16; ++j) { const unsigned c = xb_ld(&bar[XB_XCNT(j)]); sum += c; cnt += (c > 0u) ? 1u : 0u; mine = (j == x) ? c : mine; }
        if (sum == G) break;
        __builtin_amdgcn_s_sleep(1);
        if ((++sp & 255u) == 0u) { if (xb_ld(&bar[XB_TMO])) break; if (sp > XB_SPIN_CAP) { atomicAdd(&bar[XB_TMO], 1u); break; } }
    }
    nloc = mine > 0u ? mine : 1u; nx = cnt > 0u ? cnt : 1u;
}
__device__ __forceinline__ void xcd_barrier(const XcdBarrier& b) {
    asm volatile("s_waitcnt vmcnt(0)" ::: "memory");
    __syncthreads();
    if (threadIdx.x == 0) {
        unsigned* bar = b.bar;
        __builtin_amdgcn_s_waitcnt(0);
        unsigned nloc = b.st[0], nx = b.st[1];
        if (nloc == 0u) { xcd_barrier_complete(bar, b.x, nloc, nx); b.st[0] = nloc; b.st[1] = nx; }
        const unsigned old = xb_add(&bar[XB_XSUB(b.x)], 1u);
        const unsigned gen = old / nloc;
        if (old + 1u == (gen + 1u) * nloc) {
            __builtin_amdgcn_fence(__ATOMIC_RELEASE, "agent");
            asm volatile("s_waitcnt vmcnt(0)" ::: "memory");
            const unsigned og = xb_add(&bar[XB_TOP], 1u);
            const unsigned tg = og / nx;
            if (og + 1u == (tg + 1u) * nx) xb_add(&bar[XB_TOPGEN], 1u);
            else XB_SPIN(xb_ld(&bar[XB_TOPGEN]) == tg, bar);
            __builtin_amdgcn_fence(__ATOMIC_ACQUIRE, "agent");
            xb_add(&bar[XB_XGEN(b.x)], 1u);
            asm volatile("s_waitcnt vmcnt(0)" ::: "memory");
        } else {
            XB_SPIN(xb_ld(&bar[XB_XGEN(b.x)]) == gen, bar);
            __builtin_amdgcn_fence(__ATOMIC_ACQUIRE, "agent");
            asm volatile("s_waitcnt vmcnt(0)" ::: "memory");
        }
    }
    __syncthreads();
}

__global__ void __launch_bounds__(NTHREADS, 2) fwd_megakernel(Args a) {
    extern __shared__ __attribute__((aligned(16))) unsigned char lds_raw[];
    cg::grid_group grid = cg::this_grid();
    LAS unsigned char* lds = (LAS unsigned char*)lds_raw;
    const int G = gridDim.x, bx = blockIdx.x;
    const int vcu = (G % 8 == 0) ? (bx % 8) * (G / 8) + bx / 8 : bx;
    unsigned char* ws = a.ws;
    if (ws == nullptr) grid.sync();
    volatile LAS unsigned* bst = (volatile LAS unsigned*)(lds + LDS_BYTES - 64);
    if (threadIdx.x < 2) bst[threadIdx.x] = 0u;
    __syncthreads();
    const XcdBarrier bar = xcd_barrier_post((unsigned*)ws, bst);
#pragma unroll 1
    for (int step = 0; step < 14; ++step) {
        const int layer = step / 7, ph = step - 7 * layer;
#ifndef NO_PREP
        if (ph == 0) { for (int rep = 0; rep < PROBE_REP_PREP; ++rep) prep_phase(a, layer, lds, vcu, G); }
        else
#endif
        if (ph == 1 || ph >= 5) {
#ifndef NO_GEMM
            if (ph == 1) cumsum_phase(a, bx);
            pg8::Sched S; S.kind = ph == 1 ? 0 : (ph == 5 ? 1 : 2); S.so.init(M, ph == 1 ? NP : 1024, G, bx);
            pg8::Epi E; E.QKVZ = (bf16_t*)(ws + WS_QKVZ); E.Gt = (bf16_t*)(ws + WS_G); E.MERGED = (bf16_t*)(ws + WS_QKVZ);
            E.xin = layer == 0 ? a.x : a.out; E.xout = a.out; E.cosT = (const float*)(ws + WS_COS); E.sinT = (const float*)(ws + WS_SIN);
            E.gfin = layer == 0 ? a.norm_g + D : a.final_g; E.Hout = (bf16_t*)(ws + WS_H); E.slots = (unsigned*)(ws + WS_SLOTS); E.cnt = (unsigned*)(ws + 16384 + layer * 32768); E.xl = lds + 131072;
            const bf16_t* A = ph == 1 ? (const bf16_t*)(ws + WS_H) : (ph == 5 ? (const bf16_t*)(ws + WS_H) : (const bf16_t*)(ws + WS_QKVZ));
            const bf16_t* Bt = ph == 1 ? (const bf16_t*)(ws + WS_WIN) : (ph == 5 ? (const bf16_t*)(ws + WS_WBR) : (const bf16_t*)(ws + WS_WOUT));
#ifdef ONLY_KIND
            pg8::gemm_phase<ONLY_KIND>(lds, A, Bt, S, E);
#else
            if (ph == 1) { for (int rep = 0; rep < PROBE_REP_GEMM1; ++rep) pg8::gemm_phase<0>(lds, A, Bt, S, E); } else if (ph == 5) { for (int rep = 0; rep < PROBE_REP_MERGE; ++rep) pg8::gemm_phase<1>(lds, A, Bt, S, E); } else if (layer == 0) pg8::gemm_phase<4>(lds, A, Bt, S, E); else pg8::gemm_phase<3>(lds, A, Bt, S, E);
#endif
#endif
        }
#ifndef NO_ATTN
        else { const int nrep = ph == 2 ? PROBE_REP_ATT0 : 1; for (int rep = 0; rep < nrep; ++rep) { attn::attn_phase(a, layer, ph - 2, lds, vcu); __syncthreads(); } }
#endif
        if (step == 13) break;
        xcd_barrier(bar);
#ifdef PROBE_SYNC2
        xcd_barrier(bar);
#endif
    }
}

extern "C" void kernel_launch(void* const* d_in, const int* in_sizes, int n_in, void* d_out, int out_size, void* d_ws, size_t ws_size, hipStream_t stream) {
    static int grid = 0;
    if (grid == 0) {
        if (n_in != 10 || in_sizes[0] != M * D || out_size != M * D || ws_size < WS_END) { fprintf(stderr, "kernel_launch: unexpected shapes/workspace (n_in %d, in0 %d, out %d, ws %zu)\n", n_in, n_in > 0 ? in_sizes[0] : -1, out_size, ws_size); grid = -1; return; }
        int dev = 0, cus = 0, per_cu = 0;
        if (hipGetDevice(&dev) != hipSuccess || hipDeviceGetAttribute(&cus, hipDeviceAttributeMultiprocessorCount, dev) != hipSuccess) { grid = -1; return; }
        if (hipFuncSetAttribute((const void*)fwd_megakernel, hipFuncAttributeMaxDynamicSharedMemorySize, LDS_BYTES) != hipSuccess) { fprintf(stderr, "kernel_launch: hipFuncSetAttribute failed\n"); grid = -1; return; }
        if (hipOccupancyMaxActiveBlocksPerMultiprocessor(&per_cu, (const void*)fwd_megakernel, NTHREADS, LDS_BYTES) != hipSuccess || per_cu < 1) { fprintf(stderr, "kernel_launch: occupancy query gave %d\n", per_cu); (void)hipGetLastError(); per_cu = 1; }
        grid = cus * (per_cu > 1 ? 1 : per_cu);
    }
    if (grid < 0) return;
    if (hipMemsetAsync(d_ws, 0, 131072, stream) != hipSuccess) { fprintf(stderr, "kernel_launch: memset of barrier words failed\n"); return; }
    Args a{};
    a.x = (const float*)d_in[0]; a.norm_g = (const float*)d_in[1]; a.w_in = (const float*)d_in[2]; a.b_forget = (const float*)d_in[3]; a.sinks = (const float*)d_in[4];
    a.w_br_a = (const float*)d_in[5]; a.w_br_b = (const float*)d_in[6]; a.w_br_c = (const float*)d_in[7]; a.w_out = (const float*)d_in[8]; a.final_g = (const float*)d_in[9];
    a.out = (float*)d_out; a.ws = (unsigned char*)d_ws;
    for (int i = 0; i < 32; ++i) a.inv_freq[i] = powf(10000.0f, -(float)(2 * i) / 64.0f);
    void* args[] = {&a};
    hipError_t e = hipLaunchCooperativeKernel((const void*)fwd_megakernel, dim3(grid), dim3(NTHREADS), args, LDS_BYTES, stream);
    if (e != hipSuccess) fprintf(stderr, "kernel_launch: cooperative launch failed: %s (grid %d)\n", hipGetErrorString(e), grid);
}
```

```cpp
#include <hip/hip_runtime.h>
#include <hip/hip_cooperative_groups.h>
#include <cstdio>
#include <cstdint>
#include <cmath>
namespace cg = cooperative_groups;

#define LAS __attribute__((address_space(3)))
#define GAS __attribute__((address_space(1)))
typedef unsigned short bf16_t;
typedef short bf16x8 __attribute__((ext_vector_type(8)));
typedef short s16x4 __attribute__((ext_vector_type(4)));
typedef float f32x4 __attribute__((ext_vector_type(4)));
typedef float f32x16 __attribute__((ext_vector_type(16)));
typedef unsigned u32x4 __attribute__((ext_vector_type(4)));
typedef unsigned u32x2 __attribute__((ext_vector_type(2)));

constexpr int SEQ = 2048, NBATCH = 16, M = NBATCH * SEQ, D = 1024;
constexpr int NIN = 6660;
constexpr int NP = 6656;
constexpr int NQ = 2048;
constexpr size_t KVH_OFF = (size_t)M * NQ * 2;
constexpr int NGC = 3072;
constexpr float LOG2E = 1.4426950408889634f;
constexpr float C2 = 0.125f * LOG2E;
constexpr float RMS_EPS = 1e-6f;

constexpr size_t MiB = 1u << 20;
constexpr size_t WS_COS = 1 * MiB;
constexpr size_t WS_SIN = WS_COS + 256 * 1024;
constexpr size_t WS_LOGF = WS_SIN + 256 * 1024;
constexpr size_t WS_CB = WS_LOGF + 512 * 1024;
constexpr size_t WS_LSE = WS_CB + 512 * 1024;
constexpr size_t WS_SLOTS = 512 * 1024;
constexpr size_t WS_WIN = 4 * MiB;
constexpr size_t WS_WBR = 17 * MiB;
constexpr size_t WS_WOUT = 19 * MiB;
constexpr size_t WS_H = 22 * MiB;
constexpr size_t WS_QKVZ = 86 * MiB;
constexpr size_t WS_G = 310 * MiB;
constexpr size_t WS_END = 502 * MiB;

constexpr int LDS_BYTES = 147456;
constexpr int NTHREADS = 512;
#ifndef PROBE_REP_GEMM1
#define PROBE_REP_GEMM1 1
#endif
#ifndef PROBE_REP_MERGE
#define PROBE_REP_MERGE 1
#endif
#ifndef PROBE_REP_PREP
#define PROBE_REP_PREP 1
#endif
#ifndef PROBE_REP_ATT0
#define PROBE_REP_ATT0 1
#endif

__device__ __forceinline__ unsigned f2bf(float f) { unsigned u = __builtin_bit_cast(unsigned, f); return (u + 0x7fffu + ((u >> 16) & 1u)) >> 16; }
typedef float f32x2_t __attribute__((ext_vector_type(2))); typedef __bf16 bf16x2_t __attribute__((ext_vector_type(2)));
__device__ __forceinline__ unsigned pk2(float lo, float hi) { f32x2_t v = {lo, hi}; bf16x2_t b = __builtin_convertvector(v, bf16x2_t); return __builtin_bit_cast(unsigned, b); }
__device__ __forceinline__ float bflo(unsigned w) { return __builtin_bit_cast(float, w << 16); }
__device__ __forceinline__ float bfhi(unsigned w) { return __builtin_bit_cast(float, w & 0xffff0000u); }
__device__ __forceinline__ float ex2(float x) { return __builtin_amdgcn_exp2f(x); }
__device__ __forceinline__ float rcpf_(float x) { return __builtin_amdgcn_rcpf(x); }
__device__ __forceinline__ float bperm(float v, int src_lane) { return __builtin_bit_cast(float, __builtin_amdgcn_ds_bpermute(src_lane << 2, __builtin_bit_cast(int, v))); }

namespace pg8 {
constexpr int BM = 256, BK = 64, HALF = 128, HTB = HALF * BK * 2, STAGE_BYTES = 8 * HTB, NXCD = 8, WGM = 8, LD = 1024;
__device__ __forceinline__ int lds_byte(int r, int c) { const int st = (r >> 4) * 2 + (c >> 5), rr = r & 15, cc = c & 31, ob = rr * 64 + cc * 2; return st * 1024 + (ob ^ (((ob >> 9) & 1) << 5)); }
__device__ __forceinline__ void stage_rc(int b, int& R, int& C) { const int st = b / 1024, sb = b % 1024, swz = sb ^ (((sb >> 9) & 1) << 5); R = (st >> 1) * 16 + swz / 64; C = (st & 1) * 32 + (swz % 64) / 2; }
__device__ __forceinline__ int perm32(int rho) { const int n = rho >> 4, i = rho & 15; return 8 * (i >> 2) + 4 * n + (i & 3); }

struct Unit { int pm, pn, k0, nt, mode; };

struct StaticOrder {
    int nM, nN, nwg, G, c;
    __device__ void init(int M_, int N_, int G_, int c_) { nM = M_ / BM; nN = N_ / BM; nwg = nM * nN; G = G_; c = c_; }
    __device__ bool next(int i, Unit& u) const {
        const long L = (long)i * G + c; if (L >= nwg) return false;
        int wgid = (int)L; { const int q = nwg / NXCD, r = nwg % NXCD, xcd = wgid % NXCD, off = wgid / NXCD; wgid = (xcd < r ? xcd * (q + 1) : r * (q + 1) + (xcd - r) * q) + off; }
        const int nig = WGM * nN, gid = wgid / nig, fm = gid * WGM, gsz = (nM - fm) < WGM ? (nM - fm) : WGM;
        u.pm = fm + ((wgid % nig) % gsz); u.pn = (wgid % nig) / gsz; return true;
    }
};
struct Sched {
    StaticOrder so; int kind;
    __device__ bool next(int i, Unit& u) const {
        if (kind == 1) { const int t = i / 3, br = i - 3 * t; if (!so.next(t, u)) return false; u.k0 = br == 0 ? 0 : (br == 1 ? 256 : 640); u.nt = br == 0 ? 4 : 6; u.mode = 1 + br; return true; }
        if (!so.next(i, u)) return false; u.k0 = 0; u.nt = 16; u.mode = kind == 0 ? 0 : 4; return true;
    }
};

struct Epi {
    bf16_t* QKVZ; bf16_t* Gt; bf16_t* MERGED; const float* xin; float* xout; const float* cosT; const float* sinT;
    const float* gfin; bf16_t* Hout; unsigned* slots; unsigned* cnt; LAS unsigned char* xl;
    __device__ __forceinline__ static int blockop(int blk) {
        if (blk >= 28) return 3;
        if (blk < 8) return blk < 2 ? 1 : (blk < 6 ? 0 : 2);
        if (blk < 20) { const int t = blk - 8; return t < 3 ? 5 : (t < 6 ? 4 : (t < 9 ? 0 : 2)); }
        const int t = blk - 20; return t < 3 ? 5 : (t == 3 ? 4 : (t == 4 ? 0 : 2));
    }
    template <int KIND> __device__ __forceinline__ void run(f32x4 (&acc)[2][2][4][2], const Unit& u, int wr, int wc, int fr, int fq) const {
        const int rl = wr * 64 + fr, cl = wc * 32 + 8 * fq;
        if constexpr (KIND == 1) {
            const int br = u.mode - 1;
            const char* gbase = (const char*)Gt + br * 1024 + u.pn * BM + (size_t)u.pm * BM * NGC;
            unsigned goff = (unsigned)(rl * NGC + cl);
            const int gnext = br < 2 ? 1024 : 0;
            const bool rt = br < 2;
#pragma unroll
            for (int bj = 0; bj < 2; ++bj)
#pragma unroll
                for (int ai = 0; ai < 2; ++ai) {
                    u32x2 ga[4], gb[4];
#pragma unroll
                    for (int m = 0; m < 4; ++m) { const char* gp = gbase + (size_t)(ai * HALF + m * 16) * NGC + bj * 128 + goff; ga[m] = *(const u32x2*)gp; gb[m] = *(const u32x2*)(gp + gnext); }
#pragma unroll
                    for (int m = 0; m < 4; ++m) {
                        f32x4 f0, f1;
#define U8F(W, K) ((float)(((W) >> (8 * (K))) & 0xffu))
#pragma unroll
                        for (int e = 0; e < 4; ++e) {
                            f0[e] = U8F(ga[m].x, e) * (rt ? rcpf_(U8F(gb[m].x, e)) : (1.f / 255.f));
                            f1[e] = U8F(ga[m].y, e) * (rt ? rcpf_(U8F(gb[m].y, e)) : (1.f / 255.f));
                        }
#undef U8F
#define PKMUL_INPLACE(A, F) do { f32x2_t lo_ = {(A)[0], (A)[1]}, hi_ = {(A)[2], (A)[3]}; const f32x2_t fl_ = {(F)[0], (F)[1]}, fh_ = {(F)[2], (F)[3]}; \
        asm volatile("v_pk_mul_f32 %0, %0, %1" : "+v"(lo_) : "v"(fl_)); asm volatile("v_pk_mul_f32 %0, %0, %1" : "+v"(hi_) : "v"(fh_)); (A) = (f32x4){lo_[0], lo_[1], hi_[0], hi_[1]}; } while (0)
                        PKMUL_INPLACE(acc[ai][bj][m][0], f0); PKMUL_INPLACE(acc[ai][bj][m][1], f1);
                    }
                    asm volatile("" : "+v"(goff));
                }
            if (br == 2) {
                char* mbase = (char*)(MERGED + u.pn * BM) + (size_t)u.pm * BM * 1024 * 2;
                const unsigned moff = (unsigned)(rl * 1024 + cl) * 2u;
#pragma unroll
                for (int bj = 0; bj < 2; ++bj)
#pragma unroll
                    for (int ai = 0; ai < 2; ++ai)
#pragma unroll
                        for (int m = 0; m < 4; ++m) {
                            const f32x4 v0 = acc[ai][bj][m][0], v1 = acc[ai][bj][m][1];
                            u32x4 w; w.x = pk2(v0[0], v0[1]); w.y = pk2(v0[2], v0[3]); w.z = pk2(v1[0], v1[1]); w.w = pk2(v1[2], v1[3]);
                            *(u32x4*)(mbase + (size_t)(ai * HALF + m * 16) * 2048 + bj * 256 + moff) = w;
                        }
            }
            const float keep = br == 2 ? 0.f : 1.f;
#pragma unroll
            for (int bj = 0; bj < 2; ++bj)
#pragma unroll
                for (int ai = 0; ai < 2; ++ai)
#pragma unroll
                    for (int m = 0; m < 4; ++m) { const f32x4 k4 = (f32x4){keep, keep, keep, keep}; PKMUL_INPLACE(acc[ai][bj][m][0], k4); PKMUL_INPLACE(acc[ai][bj][m][1], k4); }
            return;
        }
        if constexpr (KIND == 0) {
            const unsigned toff = (unsigned)(rl * 32 + 16 * (wc & 1) + 4 * fq) * 4u;
            const char* cbase = (const char*)cosT + (size_t)((u.pm & 7) * 256) * 128; const char* sbase = (const char*)sinT + (size_t)((u.pm & 7) * 256) * 128;
#pragma unroll
            for (int bj = 0; bj < 2; ++bj) {
                const int blk = 2 * u.pn + bj, op = blockop(blk);
                int ld; char* base; unsigned voff;
                if (blk >= 28) { ld = NGC / 2; base = (char*)Gt + (blk - 28) * 128 + (size_t)u.pm * BM * NGC; voff = (unsigned)(rl * NGC + cl); }
                else if (op == 0 || op == 4) {
                    const int plane0 = blk < 4 ? (blk - 2) * 2 : (blk < 6 ? 12 + (blk - 4) * 2 : (blk < 14 ? 4 + (blk - 11) * 2 : (blk < 17 ? 16 + (blk - 14) * 2 : (blk == 23 ? 10 : 22))));
                    ld = 64; base = (char*)QKVZ + KVH_OFF + ((size_t)((plane0 + (wc >> 1)) * NBATCH + (u.pm >> 3)) * SEQ + (size_t)(u.pm & 7) * BM) * 128;
                    voff = (unsigned)(rl * 64 + (wc & 1) * 32 + 8 * fq) * 2u;
                } else {
                    const int qzc = blk < 2 ? blk * 128 : (blk < 8 ? 256 + (blk - 6) * 128 : (blk < 11 ? 512 + (blk - 8) * 128 : (blk < 20 ? 896 + (blk - 17) * 128 : (blk < 23 ? 1280 + (blk - 20) * 128 : 1664 + (blk - 25) * 128))));
                    ld = NQ; base = (char*)(QKVZ + qzc) + (size_t)u.pm * BM * ld * 2; voff = (unsigned)(rl * ld + cl) * 2u;
                }
                if (op >= 4) {
                    const float sc = op == 5 ? C2 : 1.f;
                    f32x4 c4[8], s4[8];
#pragma unroll
                    for (int q = 0; q < 8; ++q) { const int dr = (q >> 2) * HALF + (q & 3) * 16; c4[q] = *(const f32x4*)(cbase + dr * 128 + toff); s4[q] = *(const f32x4*)(sbase + dr * 128 + toff); }
                    asm volatile("" ::: "memory");
#pragma unroll
                    for (int q = 0; q < 8; ++q) {
                        const int ai = q >> 2, m = q & 3, dr = ai * HALF + m * 16;
                        const f32x4 v0 = acc[ai][bj][m][0], v1 = acc[ai][bj][m][1];
                        const f32x4 cc = c4[q] * sc, ss = s4[q] * sc;
                        u32x4 w;
                        w.x = pk2(v0[0] * cc[0] - v0[1] * ss[0], v0[1] * cc[0] + v0[0] * ss[0]);
                        w.y = pk2(v0[2] * cc[1] - v0[3] * ss[1], v0[3] * cc[1] + v0[2] * ss[1]);
                        w.z = pk2(v1[0] * cc[2] - v1[1] * ss[2], v1[1] * cc[2] + v1[0] * ss[2]);
                        w.w = pk2(v1[2] * cc[3] - v1[3] * ss[3], v1[3] * cc[3] + v1[2] * ss[3]);
                        __builtin_nontemporal_store(w, (u32x4*)(base + (size_t)dr * ld * 2 + voff));
                    }
                    asm volatile("" ::: "memory");
                } else if (op >= 2) {
#pragma unroll
                    for (int ai = 0; ai < 2; ++ai)
#pragma unroll
                        for (int m = 0; m < 4; ++m) {
                            const int dr = ai * HALF + m * 16;
                            f32x4 v0 = acc[ai][bj][m][0], v1 = acc[ai][bj][m][1];
#pragma unroll
                            for (int e = 0; e < 4; ++e) {
                                const float s0 = rcpf_(1.f + ex2(-LOG2E * v0[e])), s1 = rcpf_(1.f + ex2(-LOG2E * v1[e]));
                                v0[e] = op == 2 ? v0[e] * s0 : s0; v1[e] = op == 2 ? v1[e] * s1 : s1;
                            }
                            if (op == 3) {
                                u32x2 wq; unsigned q0 = 0, q1 = 0;
#pragma unroll
                                for (int e = 0; e < 4; ++e) { q0 |= (unsigned)fminf(fmaxf(v0[e] * 255.f + 0.5f, 1.f), 255.f) << (8 * e); q1 |= (unsigned)fminf(fmaxf(v1[e] * 255.f + 0.5f, 1.f), 255.f) << (8 * e); }
                                wq.x = q0; wq.y = q1;
                                __builtin_nontemporal_store(wq, (u32x2*)(base + (size_t)dr * ld * 2 + voff));
                            } else {
                                u32x4 w; w.x = pk2(v0[0], v0[1]); w.y = pk2(v0[2], v0[3]); w.z = pk2(v1[0], v1[1]); w.w = pk2(v1[2], v1[3]);
                                __builtin_nontemporal_store(w, (u32x4*)(base + (size_t)dr * ld * 2 + voff));
                            }
                            asm volatile("" ::: "memory");
                        }
                } else {
                    const float sc = op == 1 ? C2 : 1.f;
#pragma unroll
                    for (int ai = 0; ai < 2; ++ai)
#pragma unroll
                        for (int m = 0; m < 4; ++m) {
                            const int dr = ai * HALF + m * 16;
                            const f32x4 v0 = acc[ai][bj][m][0] * sc, v1 = acc[ai][bj][m][1] * sc;
                            u32x4 w; w.x = pk2(v0[0], v0[1]); w.y = pk2(v0[2], v0[3]); w.z = pk2(v1[0], v1[1]); w.w = pk2(v1[2], v1[3]);
                            __builtin_nontemporal_store(w, (u32x4*)(base + (size_t)dr * ld * 2 + voff));
                            asm volatile("" ::: "memory");
                        }
                }
            }
        } else if constexpr (KIND == 3 || KIND == 4) {
            const int tid = (wr * 4 + wc) * 64 + fq * 16 + fr;
            const char* ib = (const char*)(xin + u.pn * BM) + (size_t)u.pm * BM * 4096; char* ob = (char*)(xout + u.pn * BM) + (size_t)u.pm * BM * 4096;
            const unsigned xoff = (unsigned)(rl * 1024 + cl) * 4u;
#define PKADD_INPLACE(A, X) do { f32x2_t lo_ = {(A)[0], (A)[1]}, hi_ = {(A)[2], (A)[3]}; const f32x2_t xl_ = {(X)[0], (X)[1]}, xh_ = {(X)[2], (X)[3]}; \
        asm volatile("v_pk_add_f32 %0, %0, %1" : "+v"(lo_) : "v"(xl_)); asm volatile("v_pk_add_f32 %0, %0, %1" : "+v"(hi_) : "v"(xh_)); (A) = (f32x4){lo_[0], lo_[1], hi_[0], hi_[1]}; } while (0)
            unsigned xo = xoff;
#pragma unroll
            for (int bj = 0; bj < 2; ++bj) {
                f32x4 x0[8], x1[8];
#pragma unroll
                for (int q = 0; q < 8; ++q) { const size_t uo = (size_t)((q >> 2) * HALF + (q & 3) * 16) * 4096 + bj * 512; x0[q] = __builtin_nontemporal_load((const f32x4*)(ib + uo + xo)); x1[q] = __builtin_nontemporal_load((const f32x4*)(ib + uo + xo + 16)); }
#pragma unroll
                for (int q = 0; q < 8; ++q) { PKADD_INPLACE(acc[q >> 2][bj][q & 3][0], x0[q]); PKADD_INPLACE(acc[q >> 2][bj][q & 3][1], x1[q]); }
                asm volatile("" : "+v"(xo));
            }
            LAS float* P = (LAS float*)xl;
            LAS float* Sr = (LAS float*)(xl + 4096);
#pragma unroll
            for (int ai = 0; ai < 2; ++ai)
#pragma unroll
                for (int m = 0; m < 4; ++m) {
                    float sq = 0.f;
#pragma unroll
                    for (int bj = 0; bj < 2; ++bj)
#pragma unroll
                        for (int n = 0; n < 2; ++n) { const f32x4 v = acc[ai][bj][m][n]; sq += (v[0] * v[0] + v[1] * v[1]) + (v[2] * v[2] + v[3] * v[3]); }
                    sq += bperm(sq, (fq * 16 + fr) ^ 16); sq += bperm(sq, (fq * 16 + fr) ^ 32);
                    if (fq == 0) P[(ai * HALF + rl + m * 16) * 4 + wc] = sq;
                }
            asm volatile("s_waitcnt lgkmcnt(0)" ::: "memory"); __builtin_amdgcn_s_barrier(); asm volatile("" ::: "memory");
            if (tid < 256) {
                const f32x4 p4 = *(LAS const f32x4*)(P + tid * 4);
                __hip_atomic_store(slots + ((size_t)(u.pm * BM + tid) * 4 + u.pn), __float_as_uint((p4[0] + p4[1]) + (p4[2] + p4[3])), __ATOMIC_RELAXED, __HIP_MEMORY_SCOPE_AGENT);
            }
            asm volatile("s_waitcnt vmcnt(0)" ::: "memory"); __builtin_amdgcn_s_barrier(); asm volatile("" ::: "memory");
            if (tid == 0) {
                __hip_atomic_fetch_add(cnt + 64 * u.pm, 1u, __ATOMIC_RELAXED, __HIP_MEMORY_SCOPE_AGENT);
                unsigned sp = 0;
                while (__hip_atomic_load(cnt + 64 * u.pm, __ATOMIC_RELAXED, __HIP_MEMORY_SCOPE_AGENT) < 4u) { __builtin_amdgcn_s_sleep(2); if (++sp > (1u << 17)) break; }
                __builtin_amdgcn_fence(__ATOMIC_ACQUIRE, "agent");
            }
            asm volatile("s_waitcnt vmcnt(0) lgkmcnt(0)" ::: "memory"); __builtin_amdgcn_s_barrier(); asm volatile("" ::: "memory");
            if (tid < 256) {
                const unsigned* sl = slots + (size_t)(u.pm * BM + tid) * 4; float ss = 0.f;
#pragma unroll
                for (int t4 = 0; t4 < 4; ++t4) ss += __uint_as_float(__hip_atomic_load(sl + t4, __ATOMIC_RELAXED, __HIP_MEMORY_SCOPE_AGENT));
                Sr[tid] = 1.0f / sqrtf(ss * (1.f / 1024.f) + RMS_EPS);
            }
            asm volatile("s_waitcnt lgkmcnt(0)" ::: "memory"); __builtin_amdgcn_s_barrier(); asm volatile("" ::: "memory");
#pragma unroll
            for (int bj = 0; bj < 2; ++bj) {
                const f32x4 g0 = *(const f32x4*)(gfin + u.pn * BM + bj * HALF + cl), g1 = *(const f32x4*)(gfin + u.pn * BM + bj * HALF + cl + 4);
#pragma unroll
                for (int q = 0; q < 8; ++q) { const size_t uo = (size_t)((q >> 2) * HALF + (q & 3) * 16) * 4096 + bj * 512; const float rs = Sr[(q >> 2) * HALF + rl + (q & 3) * 16];
                    const f32x4 h0 = acc[q >> 2][bj][q & 3][0] * rs * g0, h1 = acc[q >> 2][bj][q & 3][1] * rs * g1;
                    if constexpr (KIND == 3) { __builtin_nontemporal_store(h0, (f32x4*)(ob + uo + xoff)); __builtin_nontemporal_store(h1, (f32x4*)(ob + uo + xoff + 16)); }
                    else { __builtin_nontemporal_store(acc[q >> 2][bj][q & 3][0], (f32x4*)(ob + uo + xoff)); __builtin_nontemporal_store(acc[q >> 2][bj][q & 3][1], (f32x4*)(ob + uo + xoff + 16));
                        u32x4 w; w.x = pk2(h0[0], h0[1]); w.y = pk2(h0[2], h0[3]); w.z = pk2(h1[0], h1[1]); w.w = pk2(h1[2], h1[3]);
                        *(u32x4*)((char*)(Hout + u.pn * BM) + (size_t)u.pm * BM * 2048 + (uo >> 1) + (xoff >> 1)) = w; } }
                asm volatile("" ::: "memory");
            }
            asm volatile("s_waitcnt lgkmcnt(0)" ::: "memory"); __builtin_amdgcn_s_barrier(); asm volatile("" ::: "memory");
        } else if constexpr (KIND == 2) {
            const char* ib = (const char*)(xin + u.pn * BM) + (size_t)u.pm * BM * 4096; char* ob = (char*)(xout + u.pn * BM) + (size_t)u.pm * BM * 4096;
            const unsigned xoff = (unsigned)(rl * 1024 + cl) * 4u;
#pragma unroll
            for (int bj = 0; bj < 2; ++bj) {
                f32x4 x0[8], x1[8];
#pragma unroll
                for (int q = 0; q < 8; ++q) { const size_t uo = (size_t)((q >> 2) * HALF + (q & 3) * 16) * 4096 + bj * 512; x0[q] = *(const f32x4*)(ib + uo + xoff); x1[q] = *(const f32x4*)(ib + uo + xoff + 16); }
                asm volatile("" ::: "memory");
#pragma unroll
                for (int q = 0; q < 8; ++q) { const size_t uo = (size_t)((q >> 2) * HALF + (q & 3) * 16) * 4096 + bj * 512;
                    *(f32x4*)(ob + uo + xoff) = x0[q] + acc[q >> 2][bj][q & 3][0]; *(f32x4*)(ob + uo + xoff + 16) = x1[q] + acc[q >> 2][bj][q & 3][1]; }
                asm volatile("" ::: "memory");
            }
        }
#pragma unroll
        for (int bj = 0; bj < 2; ++bj)
#pragma unroll
            for (int ai = 0; ai < 2; ++ai)
#pragma unroll
                for (int m = 0; m < 4; ++m) { acc[ai][bj][m][0] = (f32x4){0.f, 0.f, 0.f, 0.f}; acc[ai][bj][m][1] = (f32x4){0.f, 0.f, 0.f, 0.f}; }
    }
};

template <int KIND> __device__ __forceinline__ void gemm_phase(LAS unsigned char* lds, const bf16_t* A, const bf16_t* Bt, const Sched& S, const Epi& E) {
    int tid_ = threadIdx.x; asm volatile("" : "+v"(tid_));
    const int tid = tid_, wid = __builtin_amdgcn_readfirstlane(tid >> 6), lane = tid & 63, wr = wid >> 2, wc = wid & 3, fr = lane & 15, fq = lane >> 4;
    unsigned voffA[2], voffB[2];
#pragma unroll
    for (int i = 0; i < 2; ++i) { int R, C; stage_rc(tid * 16 + i * 8192, R, C); const int Rb = (R & ~31) + perm32(R & 31);
        voffA[i] = (unsigned)(R * LD + C) * 2u; voffB[i] = (unsigned)(Rb * LD + C) * 2u; }
    const size_t kstep = (size_t)(BK * 2);
    const size_t hstep = (size_t)HALF * LD * 2;
    const size_t tstep = 2 * hstep;
    const unsigned ldsw = (unsigned)wid * 1024u;
    const int aoff = lds_byte(wr * 64 + fr, fq * 8), boff = lds_byte(wc * 32 + fr, fq * 8);
#define PG8_SA(b, h) (((b) * 2 + (h)) * HTB)
#define PG8_SB(b, h) ((4 + (b) * 2 + (h)) * HTB)
#define PG8_STAGE(bufoff, gbase, voff) do { _Pragma("unroll") for (int _i = 0; _i < 2; ++_i) \
        __builtin_amdgcn_global_load_lds((const unsigned*)((const char*)(gbase) + (voff)[_i]), (LAS unsigned*)(lds + (bufoff) + ldsw + _i * 8192), 16, 0, 0); } while (0)
#define PG8_LDA(dst, b, h) do { _Pragma("unroll") for (int m = 0; m < 4; ++m) _Pragma("unroll") for (int k = 0; k < 2; ++k) dst[m][k] = *(const LAS bf16x8*)(lds + PG8_SA(b, h) + aoff + m * 2048 + k * 1024); } while (0)
#define PG8_LDB(dst, b, h) do { _Pragma("unroll") for (int n = 0; n < 2; ++n) _Pragma("unroll") for (int k = 0; k < 2; ++k) dst[n][k] = *(const LAS bf16x8*)(lds + PG8_SB(b, h) + boff + n * 2048 + k * 1024); } while (0)
#define PG8_MMA(ai, bj, At, Bt_) do { __builtin_amdgcn_s_setprio(1); _Pragma("unroll") for (int m = 0; m < 4; ++m) _Pragma("unroll") for (int n = 0; n < 2; ++n) _Pragma("unroll") for (int k = 0; k < 2; ++k) \
        acc[ai][bj][m][n] = __builtin_amdgcn_mfma_f32_16x16x32_bf16(Bt_[n][k], At[m][k], acc[ai][bj][m][n], 0, 0, 0); __builtin_amdgcn_s_setprio(0); } while (0)
#define PG8_WAIT_V(n) asm volatile("s_waitcnt vmcnt(" #n ")" ::: "memory")
#define PG8_WAIT_L(n) asm volatile("s_waitcnt lgkmcnt(" #n ")" ::: "memory")
#define PG8_BAR __builtin_amdgcn_s_barrier()
#define PG8_SCHED __builtin_amdgcn_sched_barrier(0)
    Unit cur, nxt; int ui = 0;
    if (!S.next(0, cur)) return;
    f32x4 acc[2][2][4][2];
#pragma unroll
    for (int a = 0; a < 2; ++a)
#pragma unroll
        for (int b = 0; b < 2; ++b)
#pragma unroll
            for (int m = 0; m < 4; ++m)
#pragma unroll
                for (int n = 0; n < 2; ++n) acc[a][b][m][n] = (f32x4){0.f, 0.f, 0.f, 0.f};
    bf16x8 At[4][2], B0[2][2], B1[2][2];
    const char* cA = (const char*)A + (size_t)cur.pm * tstep + (size_t)cur.k0 * 2; const char* cB = (const char*)Bt + (size_t)cur.pn * tstep + (size_t)cur.k0 * 2;
    PG8_STAGE(PG8_SB(0, 0), cB, voffB); PG8_STAGE(PG8_SB(0, 1), cB + hstep, voffB); PG8_STAGE(PG8_SA(0, 0), cA, voffA); PG8_STAGE(PG8_SA(0, 1), cA + hstep, voffA);
    if (wr == 1) PG8_BAR;
    PG8_WAIT_V(2); PG8_BAR;
    PG8_STAGE(PG8_SB(1, 0), cB + kstep, voffB); PG8_STAGE(PG8_SA(1, 0), cA + kstep, voffA); PG8_STAGE(PG8_SB(1, 1), cB + hstep + kstep, voffB);
    PG8_WAIT_V(6); PG8_BAR;
    for (;;) {
        const bool has_next = S.next(ui + 1, nxt);
        const char* nA = has_next ? (const char*)A + (size_t)nxt.pm * tstep + (size_t)nxt.k0 * 2 : cA; const char* nB = has_next ? (const char*)Bt + (size_t)nxt.pn * tstep + (size_t)nxt.k0 * 2 : cB;
        const int nt = cur.nt;
        for (int t = 0; t < nt; t += 2) {
            const bool last = (t == nt - 2);
            const char* a1 = cA + (size_t)(t + 1) * kstep;
            const char* a2 = last ? nA : cA + (size_t)(t + 2) * kstep; const char* b2 = last ? nB : cB + (size_t)(t + 2) * kstep;
            const char* a3 = a2 + kstep; const char* b3 = b2 + kstep;
            PG8_LDB(B0, 0, 0); PG8_LDB(B1, 0, 1); PG8_SCHED; PG8_LDA(At, 0, 0); PG8_STAGE(PG8_SA(1, 1), a1 + hstep, voffA);
            PG8_WAIT_V(8); PG8_WAIT_L(0); PG8_BAR; PG8_MMA(0, 0, At, B0); PG8_MMA(0, 1, At, B1); PG8_BAR; PG8_SCHED;
            PG8_LDA(At, 0, 1); PG8_STAGE(PG8_SB(0, 0), b2, voffB); PG8_STAGE(PG8_SB(0, 1), b2 + hstep, voffB); PG8_STAGE(PG8_SA(0, 0), a2, voffA);
            PG8_WAIT_V(8); PG8_WAIT_L(0); PG8_BAR; PG8_MMA(1, 0, At, B0); PG8_MMA(1, 1, At, B1); PG8_BAR; PG8_SCHED;
            PG8_LDB(B0, 1, 0); PG8_LDB(B1, 1, 1); PG8_SCHED; PG8_LDA(At, 1, 0); PG8_STAGE(PG8_SA(0, 1), a2 + hstep, voffA);
            PG8_WAIT_V(8); PG8_WAIT_L(0); PG8_BAR; PG8_MMA(0, 0, At, B0); PG8_MMA(0, 1, At, B1); PG8_BAR; PG8_SCHED;
            PG8_LDA(At, 1, 1); PG8_STAGE(PG8_SB(1, 0), b3, voffB); PG8_STAGE(PG8_SB(1, 1), b3 + hstep, voffB); PG8_STAGE(PG8_SA(1, 0), a3, voffA);
            PG8_WAIT_V(8); PG8_WAIT_L(0); PG8_BAR; PG8_MMA(1, 0, At, B0); PG8_MMA(1, 1, At, B1); PG8_BAR; PG8_SCHED;
        }
        if (wr == 0) PG8_BAR;
        E.template run<KIND>(acc, cur, wr, wc, fr, fq);
        if (!has_next) break;
        cur = nxt; cA = nA; cB = nB; ++ui;
        if (wr == 1) PG8_BAR;
    }
    PG8_WAIT_V(0);
    PG8_BAR;
#undef PG8_SA
#undef PG8_SB
#undef PG8_STAGE
#undef PG8_LDA
#undef PG8_LDB
#undef PG8_MMA
#undef PG8_WAIT_V
#undef PG8_WAIT_L
#undef PG8_BAR
#undef PG8_SCHED
}
}

struct Args {
    const float* x; const float* norm_g; const float* w_in; const float* b_forget; const float* sinks;
    const float* w_br_a; const float* w_br_b; const float* w_br_c; const float* w_out; const float* final_g;
    float* out; unsigned char* ws;
    float inv_freq[32];
};

__device__ __forceinline__ float wave_sum(float v, int lane) {
#pragma unroll
    for (int o = 1; o < 64; o <<= 1) v += bperm(v, lane ^ o);
    return v;
}
__device__ __forceinline__ int orig_col(int np) {
    if (np < 768) return np;
    const bool rope = (np >= 1024 && np < 1792) || (np >= 2560 && np < 3072);
    if (!rope) return np + 4;
    const int p = np & 63, base = np - p;
    return base + (p >> 1) + 32 * (p & 1) + 4;
}
__device__ __forceinline__ void transpose_item(const float* W, int ldw, bool permute, bf16_t* WT, int ldt, int kdst, LAS float* scr, int k0, int n0, int lane) {
    const int nn = n0 + (lane & 31), sc = permute ? orig_col(nn) : nn;
#pragma unroll 8
    for (int i = 0; i < 32; ++i) { const int kk = 2 * i + (lane >> 5); scr[kk * 33 + (lane & 31)] = __builtin_nontemporal_load(W + (size_t)(k0 + kk) * ldw + sc); }
    asm volatile("s_waitcnt lgkmcnt(0)" ::: "memory");
    const int c = lane & 7;
#pragma unroll
    for (int j = 0; j < 4; ++j) { const int n = (lane >> 3) + 8 * j; const LAS float* s = scr + (8 * c) * 33 + n;
        u32x4 o; o.x = pk2(s[0 * 33], s[1 * 33]); o.y = pk2(s[2 * 33], s[3 * 33]); o.z = pk2(s[4 * 33], s[5 * 33]); o.w = pk2(s[6 * 33], s[7 * 33]);
        *(u32x4*)(WT + (size_t)(n0 + n) * ldt + kdst + k0 + 8 * c) = o; }
    asm volatile("s_waitcnt lgkmcnt(0)" ::: "memory");
}

__device__ __forceinline__ void prep_phase(const Args& a, int layer, LAS unsigned char* lds, int vcu, int G) {
    int tid_ = threadIdx.x; asm volatile("" : "+v"(tid_));
    const int tid = tid_, lane = tid & 63, wave = __builtin_amdgcn_readfirstlane(tid >> 6);
    LAS float* scr = (LAS float*)(lds + wave * 16384);
    const int gw = vcu * 8 + wave, NGW = G * 8;
    unsigned char* ws = a.ws;
    const float* w_in = a.w_in + (size_t)layer * D * NIN;
    constexpr int I_IN = 16 * (NP / 32), I_A = 4 * 32, I_B = 6 * 32, I_C = 6 * 32, I_O = 16 * 32;
    constexpr int NITEMS = I_IN + I_A + I_B + I_C + I_O;
    for (int it = gw; it < NITEMS; it += NGW) {
        int r = it;
        if (r < I_IN) { const int nb = r % (NP / 32), kb = r / (NP / 32); transpose_item(w_in, NIN, true, (bf16_t*)(ws + WS_WIN), 1024, 0, scr, 64 * kb, 32 * nb, lane); continue; } r -= I_IN;
        if (r < I_A) { transpose_item(a.w_br_a + (size_t)layer * 256 * 1024, 1024, false, (bf16_t*)(ws + WS_WBR), 1024, 0, scr, 64 * (r / 32), 32 * (r % 32), lane); continue; } r -= I_A;
        if (r < I_B) { transpose_item(a.w_br_b + (size_t)layer * 384 * 1024, 1024, false, (bf16_t*)(ws + WS_WBR), 1024, 256, scr, 64 * (r / 32), 32 * (r % 32), lane); continue; } r -= I_B;
        if (r < I_C) { transpose_item(a.w_br_c + (size_t)layer * 384 * 1024, 1024, false, (bf16_t*)(ws + WS_WBR), 1024, 640, scr, 64 * (r / 32), 32 * (r % 32), lane); continue; } r -= I_C;
        transpose_item(a.w_out + (size_t)layer * 1024 * 1024, 1024, false, (bf16_t*)(ws + WS_WOUT), 1024, 0, scr, 64 * (r / 32), 32 * (r % 32), lane);
    }
    if (layer == 0) {
        float* cosT = (float*)(ws + WS_COS); float* sinT = (float*)(ws + WS_SIN);
        for (int e = vcu * NTHREADS + tid; e < SEQ * 32; e += G * NTHREADS) {
            const int pos = e >> 5, i = e & 31;
            const float angf = (float)pos * a.inv_freq[i];
            const double ang = (double)angf;
            const double n = __builtin_rint(ang * 0.15915494309189535);
            double r = ang - n * 6.283185307179586232; r -= n * 2.449293598294706414e-16;
            const double r2 = r * r;
            double cs = 1.0, sn = 1.0;
            double cc = 0.0, ss = 0.0;
#pragma unroll
            for (int k = 13; k >= 1; --k) { cc = (cc + 1.0) * (-r2 / (double)((2 * k - 1) * (2 * k))); ss = (ss + 1.0) * (-r2 / (double)((2 * k) * (2 * k + 1))); }
            cs = 1.0 + cc; sn = r * (1.0 + ss);
            cosT[e] = (float)cs; sinT[e] = (float)sn;
        }
    }
    const float* xin = layer == 0 ? a.x : a.out;
    const float* g = a.norm_g + layer * D;
    f32x4 gv[4], wf[16];
#pragma unroll
    for (int j = 0; j < 4; ++j) gv[j] = *(const f32x4*)(g + 256 * j + 4 * lane);
#pragma unroll
    for (int j = 0; j < 4; ++j)
#pragma unroll
        for (int e = 0; e < 4; ++e) wf[4 * j + e] = *(const f32x4*)(w_in + (size_t)(256 * j + 4 * lane + e) * NIN + 768);
    const f32x4 bfv = *(const f32x4*)(a.b_forget + 4 * layer);
    bf16_t* H = (bf16_t*)(ws + WS_H); float* logf = (float*)(ws + WS_LOGF);
    if (layer > 0) {
        for (int m = gw; m < M; m += NGW) {
            const u32x2* hr = (const u32x2*)(H + (size_t)m * D) + lane;
            f32x4 fa = (f32x4){0.f, 0.f, 0.f, 0.f};
#pragma unroll
            for (int j = 0; j < 4; ++j) { const u32x2 hw = hr[64 * j];
                fa += wf[4 * j + 0] * bflo(hw.x); fa += wf[4 * j + 1] * bfhi(hw.x); fa += wf[4 * j + 2] * bflo(hw.y); fa += wf[4 * j + 3] * bfhi(hw.y); }
            fa.x = wave_sum(fa.x, lane); fa.y = wave_sum(fa.y, lane); fa.z = wave_sum(fa.z, lane); fa.w = wave_sum(fa.w, lane);
            if (lane == 0) {
                f32x4 o;
#pragma unroll
                for (int e = 0; e < 4; ++e) { const float t = fa[e] + bfv[e]; o[e] = fminf(t, 0.f) - log1pf(expf(-fabsf(t))); }
                *(f32x4*)(logf + (size_t)m * 4) = o;
            }
        }
        return;
    }
    for (int m = gw; m < M; m += NGW) {
        const f32x4* xr = (const f32x4*)(xin + (size_t)m * D) + lane;
        f32x4 v[4]; float s2 = 0.f;
#pragma unroll
        for (int j = 0; j < 4; ++j) { v[j] = __builtin_nontemporal_load(xr + 64 * j); s2 += (v[j].x * v[j].x + v[j].y * v[j].y) + (v[j].z * v[j].z + v[j].w * v[j].w); }
        const float rs = 1.0f / sqrtf(wave_sum(s2, lane) * (1.f / D) + RMS_EPS);
        f32x4 fa = (f32x4){0.f, 0.f, 0.f, 0.f};
        unsigned long long* o8 = (unsigned long long*)(H + (size_t)m * D) + lane;
#pragma unroll
        for (int j = 0; j < 4; ++j) {
            const f32x4 h = v[j] * rs * gv[j];
            fa += wf[4 * j + 0] * h.x; fa += wf[4 * j + 1] * h.y; fa += wf[4 * j + 2] * h.z; fa += wf[4 * j + 3] * h.w;
            o8[64 * j] = (unsigned long long)pk2(h.x, h.y) | ((unsigned long long)pk2(h.z, h.w) << 32);
        }
        fa.x = wave_sum(fa.x, lane); fa.y = wave_sum(fa.y, lane); fa.z = wave_sum(fa.z, lane); fa.w = wave_sum(fa.w, lane);
        if (lane == 0) {
            f32x4 o;
#pragma unroll
            for (int e = 0; e < 4; ++e) { const float t = fa[e] + bfv[e]; o[e] = fminf(t, 0.f) - log1pf(expf(-fabsf(t))); }
            *(f32x4*)(logf + (size_t)m * 4) = o;
        }
    }
}

__device__ __forceinline__ void cumsum_phase(const Args& a, int blk) {
    if (blk >= 8) return;
    int tid_ = threadIdx.x; asm volatile("" : "+v"(tid_));
    const int tid = tid_, lane = tid & 63, w = tid >> 6, seq = blk * 8 + w, b = seq >> 2, h = seq & 3;
    const float* lf = (const float*)(a.ws + WS_LOGF) + ((size_t)b * SEQ + 32 * lane) * 4 + h;
    float* cb = (float*)(a.ws + WS_CB) + (size_t)(b * 4 + h) * SEQ + 32 * lane;
    float v[32]; float run = 0.f;
#pragma unroll
    for (int i = 0; i < 32; ++i) { run += lf[4 * i]; v[i] = run; }
    float x = run;
#pragma unroll
    for (int o = 1; o < 64; o <<= 1) { const float t = bperm(x, lane >= o ? lane - o : lane); if (lane >= o) x += t; }
    const float excl = x - run;
#pragma unroll
    for (int i = 0; i < 32; i += 4) { f32x4 o4; o4.x = -LOG2E * (excl + v[i]); o4.y = -LOG2E * (excl + v[i + 1]); o4.z = -LOG2E * (excl + v[i + 2]); o4.w = -LOG2E * (excl + v[i + 3]); *(f32x4*)(cb + i) = o4; }
}

namespace attn {
constexpr int KPL = 2064;
constexpr int VPL = 8256;
constexpr int OFF_V = 8 * KPL;
constexpr int OFF_B = OFF_V + 2 * VPL;
constexpr int BUF = OFF_B + 512;
constexpr int NBUF = 3;
constexpr int OFF_WS = NBUF * BUF;
constexpr int OFF_ST = OFF_WS + 8 * 256;
constexpr int ST_BYTES = 32 * 144;
static_assert(OFF_ST + 8 * ST_BYTES <= LDS_BYTES - 256, "attention LDS map");

struct Item { int valid, type, b, h, qcol, kcol, vcol, zcol, ycol, dil, res0, M0, c0, c1, W; };

__device__ __forceinline__ Item make_item(int sub, int g, int j) {
    Item it; it.valid = 0; it.type = 0; it.b = 0; it.h = 0; it.qcol = 0; it.kcol = 0; it.vcol = 0; it.zcol = 0; it.ycol = 0; it.dil = 1; it.res0 = 0; it.M0 = 0; it.c0 = 0; it.c1 = 1; it.W = 128;
    if (sub == 0) {
        if (j >= 8) return it;
        it.valid = 1;
        if (j < 2) {
            const int bh = g >> 2, s = g & 3, qb = j == 0 ? s : 7 - s, h = bh & 3;
            it.type = 0; it.b = bh >> 2; it.h = h; it.qcol = 64 * h; it.kcol = h; it.vcol = 12 + h; it.zcol = 256 + 64 * h; it.ycol = 64 * h;
            it.M0 = 256 * qb; it.c0 = 0; it.c1 = 2 * (qb + 1); it.W = 1 << 30; return it;
        }
        const bool isC = j >= 5; const int idx = g * 3 + (j - (isC ? 5 : 2)), b = idx / 48, rem = idx % 48, h = rem >> 3, blk = rem & 7;
        it.b = b; it.h = h; it.M0 = 256 * blk; it.c0 = blk == 0 ? 1 : 0; it.c1 = 3;
        const int kvh = h / 3;
        it.type = isC ? 4 : 1; it.qcol = (isC ? 1280 : 512) + 64 * h; it.kcol = isC ? 10 + kvh : 4 + h; it.vcol = isC ? 22 + kvh : 16 + h;
        it.zcol = (isC ? 1664 : 896) + 64 * h; it.ycol = (isC ? 640 : 256) + 64 * h; it.W = isC ? 127 : 128;
        return it;
    }
    if (j >= 3) return it;
    it.valid = 1;
    const int idx = g * 3 + j, b = idx / 48, rem = idx % 48, h = rem >> 3, r8 = rem & 7;
    it.b = b; it.h = h; it.qcol = 512 + 64 * h; it.kcol = 4 + h; it.vcol = 16 + h; it.zcol = 896 + 64 * h; it.ycol = 256 + 64 * h; it.W = 128;
    const int blk = r8 & 1;
    it.type = sub == 1 ? 2 : 3; it.dil = sub == 1 ? 4 : 16; it.res0 = sub == 1 ? (r8 >> 1) : 2 * r8; it.M0 = sub == 1 ? 256 * blk : 0; it.c0 = (sub == 1 && blk == 0) ? 1 : 0; it.c1 = sub == 1 ? 3 : 2;
    return it;
}
__device__ __forceinline__ void chunk_src(const Item& it, int c, int& kp0, int& kres) {
    if (it.type == 0) { kp0 = 128 * c; kres = 0; }
    else if (it.type == 3) { kp0 = 0; kres = it.res0 + c; }
    else { kp0 = it.M0 - 128 + 128 * c; kres = it.res0; }
}
__device__ __forceinline__ s16x4 vtr(LAS const unsigned char* p) {
    typedef short v4i16_t __attribute__((ext_vector_type(4)));
    return __builtin_bit_cast(s16x4, __builtin_amdgcn_ds_read_tr16_b64_v4i16((LAS v4i16_t*)p));
}

__device__ __forceinline__ void attn_phase(const Args& a, int layer, int sub, LAS unsigned char* lds, int g) {
    int tid_ = threadIdx.x; asm volatile("" : "+v"(tid_));
    const int tid = tid_, lane = tid & 63, w = __builtin_amdgcn_readfirstlane(tid >> 6), hi = lane >> 5, l31 = lane & 31;
    const bf16_t* QKVZ = (const bf16_t*)(a.ws + WS_QKVZ); const bf16_t* KVH = (const bf16_t*)(a.ws + WS_QKVZ + KVH_OFF); bf16_t* Y = (bf16_t*)(a.ws + WS_H); float* LSE = (float*)(a.ws + WS_LSE); const float* CB = (const float*)(a.ws + WS_CB);
    LAS float* wsf = (LAS float*)(lds + OFF_WS + w * 256);
    LAS bf16_t* stg = (LAS bf16_t*)(lds + OFF_ST + w * ST_BYTES);
    int j = 0, cb;
    { const Item it0 = make_item(sub, g, 0); if (!it0.valid) return; cb = it0.c0; }
    u32x4 kreg[NBUF][2], vreg[NBUF][2]; float breg[NBUF]; bf16x8 qn[4];
#define ATT_ISSUE(IT, CBEG, NCH) do { _Pragma("unroll") for (int ci_ = 0; ci_ < NBUF; ++ci_) if (ci_ < (NCH)) { int kp0_, kres_; chunk_src(IT, (CBEG) + ci_, kp0_, kres_); \
        _Pragma("unroll") for (int i_ = 0; i_ < 2; ++i_) { const int p_ = tid + 512 * i_, key_ = p_ >> 3, c16_ = p_ & 7; int m_ = kp0_ + key_; m_ = m_ < 0 ? 0 : m_; \
            const size_t ro_ = (size_t)((IT).b * SEQ + m_ * (IT).dil + kres_) * 64 + c16_ * 8; \
            kreg[ci_][i_] = *(const u32x4*)(KVH + (size_t)(IT).kcol * (NBATCH * SEQ * 64) + ro_); vreg[ci_][i_] = *(const u32x4*)(KVH + (size_t)(IT).vcol * (NBATCH * SEQ * 64) + ro_); } \
        breg[ci_] = CB[(size_t)((IT).b * 4 + ((IT).h & 3)) * SEQ + ((kp0_ + (tid & 127)) & (SEQ - 1))]; } \
        if ((CBEG) == (IT).c0) { const int qres_ = (IT).type == 3 ? (IT).res0 + (w >> 2) : (IT).res0, mq0_ = (IT).type == 3 ? 32 * (w & 3) : (IT).M0 + 32 * w; \
            const bf16_t* qp_ = QKVZ + (size_t)((IT).b * SEQ + (mq0_ + l31) * (IT).dil + qres_) * NQ + (IT).qcol + 8 * hi; \
            _Pragma("unroll") for (int s_ = 0; s_ < 4; ++s_) qn[s_] = *(const bf16x8*)(qp_ + 16 * s_); } } while (0)
    { const Item it0 = make_item(sub, g, 0); const int n0 = it0.c1 - cb < NBUF ? it0.c1 - cb : NBUF; ATT_ISSUE(it0, cb, n0); }
    bf16x8 qf[4]; f32x16 o0, o1; float mrun = -1e30f, lrun = 0.f;
    for (;;) {
        const Item it = make_item(sub, g, j);
        const int nch = it.c1 - cb < NBUF ? it.c1 - cb : NBUF;
        int ncb = cb + nch, nj = j;
        if (ncb >= it.c1) nj = j + 1;
        const Item nx = make_item(sub, g, nj);
        const bool has_next = nx.valid != 0;
        if (nj != j) ncb = nx.c0;
        const int nnch = nx.c1 - ncb < NBUF ? nx.c1 - ncb : NBUF;
        __syncthreads();
#pragma unroll
        for (int ci = 0; ci < NBUF; ++ci) if (ci < nch) {
            LAS unsigned char* wb = lds + ci * BUF;
#pragma unroll
            for (int i = 0; i < 2; ++i) { const int p = tid + 512 * i, key = p >> 3, c16 = p & 7;
                *(LAS u32x4*)(wb + c16 * KPL + key * 16) = kreg[ci][i];
                *(LAS u32x4*)(wb + OFF_V + (c16 >> 2) * VPL + (key >> 3) * 512 + (key & 7) * 64 + (c16 & 3) * 16) = vreg[ci][i]; }
            if (tid < 128) *(LAS float*)(wb + OFF_B + tid * 4) = breg[ci];
        }
        __syncthreads();
        const int qres = it.type == 3 ? it.res0 + (w >> 2) : it.res0;
        const int mq0 = it.type == 3 ? 32 * (w & 3) : it.M0 + 32 * w;
        if (cb == it.c0) {
#pragma unroll
            for (int s = 0; s < 4; ++s) qf[s] = qn[s];
        }
        if (has_next) ATT_ISSUE(nx, ncb, nnch);
        if (cb == it.c0) {
#pragma unroll
            for (int r = 0; r < 16; ++r) { o0[r] = 0.f; o1[r] = 0.f; }
            mrun = -1e30f; lrun = 0.f;
        }
#pragma unroll 1
        for (int ci = 0; ci < nch; ++ci) {
        const int c = cb + ci;
        LAS unsigned char* buf = lds + ci * BUF;
        int kp0, kres; chunk_src(it, c, kp0, kres);
        if (kres == qres) {
#pragma unroll 1
            for (int jp = 0; jp < 2; ++jp) {
                const int a0 = kp0 + 64 * jp;
                if (a0 > mq0 + 31 || a0 + 63 < mq0 - it.W || a0 + 63 < 0) continue;
                const bool needmask = !(a0 + 63 <= mq0 && a0 >= mq0 + 31 - it.W && a0 >= 0);
                LAS const unsigned char* kb = buf + hi * KPL + (64 * jp + l31) * 16;
                const bf16x8 kf0 = *(LAS const bf16x8*)(kb), kf1 = *(LAS const bf16x8*)(kb + 2 * KPL), kf2 = *(LAS const bf16x8*)(kb + 4 * KPL), kf3 = *(LAS const bf16x8*)(kb + 6 * KPL);
                const bf16x8 kg0 = *(LAS const bf16x8*)(kb + 512), kg1 = *(LAS const bf16x8*)(kb + 512 + 2 * KPL), kg2 = *(LAS const bf16x8*)(kb + 512 + 4 * KPL), kg3 = *(LAS const bf16x8*)(kb + 512 + 6 * KPL);
                f32x16 s, t;
                if (it.type == 0) {
#pragma unroll
                    for (int g4 = 0; g4 < 4; ++g4) { const f32x4 bv = *(LAS const f32x4*)(buf + OFF_B + (64 * jp + 8 * g4 + 4 * hi) * 4), bw = *(LAS const f32x4*)(buf + OFF_B + (64 * jp + 32 + 8 * g4 + 4 * hi) * 4);
                        s[4 * g4] = bv.x; s[4 * g4 + 1] = bv.y; s[4 * g4 + 2] = bv.z; s[4 * g4 + 3] = bv.w; t[4 * g4] = bw.x; t[4 * g4 + 1] = bw.y; t[4 * g4 + 2] = bw.z; t[4 * g4 + 3] = bw.w; }
                    s = __builtin_amdgcn_mfma_f32_32x32x16_bf16(kf0, qf[0], s, 0, 0, 0);
                    t = __builtin_amdgcn_mfma_f32_32x32x16_bf16(kg0, qf[0], t, 0, 0, 0);
                } else {
                    const f32x16 z16 = {0.f, 0.f, 0.f, 0.f, 0.f, 0.f, 0.f, 0.f, 0.f, 0.f, 0.f, 0.f, 0.f, 0.f, 0.f, 0.f};
                    s = __builtin_amdgcn_mfma_f32_32x32x16_bf16(kf0, qf[0], z16, 0, 0, 0);
                    t = __builtin_amdgcn_mfma_f32_32x32x16_bf16(kg0, qf[0], z16, 0, 0, 0);
                }
                s = __builtin_amdgcn_mfma_f32_32x32x16_bf16(kf1, qf[1], s, 0, 0, 0);
                t = __builtin_amdgcn_mfma_f32_32x32x16_bf16(kg1, qf[1], t, 0, 0, 0);
                s = __builtin_amdgcn_mfma_f32_32x32x16_bf16(kf2, qf[2], s, 0, 0, 0);
                t = __builtin_amdgcn_mfma_f32_32x32x16_bf16(kg2, qf[2], t, 0, 0, 0);
                s = __builtin_amdgcn_mfma_f32_32x32x16_bf16(kf3, qf[3], s, 0, 0, 0);
                t = __builtin_amdgcn_mfma_f32_32x32x16_bf16(kg3, qf[3], t, 0, 0, 0);
                LAS const unsigned char* vb = buf + OFF_V + (8 * jp) * 512 + (4 * hi + ((lane & 15) >> 2)) * 64 + ((lane >> 4) & 1) * 32 + (lane & 3) * 8;
#define ATT_VF(cc, ks) ({ const s16x4 lo_ = vtr(vb + (cc) * VPL + (2 * (ks)) * 512), hi_ = vtr(vb + (cc) * VPL + (2 * (ks) + 1) * 512); (bf16x8){lo_[0], lo_[1], lo_[2], lo_[3], hi_[0], hi_[1], hi_[2], hi_[3]}; })
                const bf16x8 v00 = ATT_VF(0, 0), v01 = ATT_VF(0, 1), v02 = ATT_VF(0, 2), v03 = ATT_VF(0, 3), v10 = ATT_VF(1, 0), v11 = ATT_VF(1, 1), v12 = ATT_VF(1, 2), v13 = ATT_VF(1, 3);
#undef ATT_VF
                if (needmask) {
                    const int qpos = mq0 + l31;
#pragma unroll
                    for (int r = 0; r < 16; ++r) { const int kpos = a0 + (r & 3) + 8 * (r >> 2) + 4 * hi; const bool ok = kpos >= 0 && kpos <= qpos && qpos - kpos <= it.W; s[r] = ok ? s[r] : -INFINITY;
                        const int kp2 = kpos + 32; const bool ok2 = kp2 >= 0 && kp2 <= qpos && qpos - kp2 <= it.W; t[r] = ok2 ? t[r] : -INFINITY; }
                }
                float mx = __builtin_fmaxf(__builtin_fmaxf(s[0], s[1]), t[0]), my = __builtin_fmaxf(__builtin_fmaxf(s[2], s[3]), t[1]);
                mx = __builtin_fmaxf(__builtin_fmaxf(mx, t[2]), t[3]);
#pragma unroll
                for (int r = 4; r < 16; r += 4) { mx = __builtin_fmaxf(__builtin_fmaxf(mx, s[r]), s[r + 1]); my = __builtin_fmaxf(__builtin_fmaxf(my, s[r + 2]), s[r + 3]); mx = __builtin_fmaxf(__builtin_fmaxf(mx, t[r]), t[r + 1]); my = __builtin_fmaxf(__builtin_fmaxf(my, t[r + 2]), t[r + 3]); }
                mx = __builtin_fmaxf(mx, my);
                { const auto rr = __builtin_amdgcn_permlane32_swap(__float_as_uint(mx), __float_as_uint(mx), false, false); mx = fmaxf(__uint_as_float(rr[0]), __uint_as_float(rr[1])); }
                const float mnew = fmaxf(mrun, mx);
                if (__any(mx > mrun + 16.0f)) {
                    const float alpha = ex2(mrun - mnew); lrun *= alpha; mrun = mnew;
                    if (hi == 0) wsf[l31] = alpha;
#pragma unroll
                    for (int g4 = 0; g4 < 4; ++g4) { const f32x4 av = *(LAS const f32x4*)(wsf + 8 * g4 + 4 * hi);
                        o0[4 * g4] *= av.x; o0[4 * g4 + 1] *= av.y; o0[4 * g4 + 2] *= av.z; o0[4 * g4 + 3] *= av.w;
                        o1[4 * g4] *= av.x; o1[4 * g4 + 1] *= av.y; o1[4 * g4 + 2] *= av.z; o1[4 * g4 + 3] *= av.w; }
                }
                float ps = 0.f, pt = 0.f;
#pragma unroll
                for (int r = 0; r < 16; ++r) { s[r] = ex2(s[r] - mrun); ps += s[r]; t[r] = ex2(t[r] - mrun); pt += t[r]; }
                lrun += ps + pt;
                u32x4 pw0, pw1, pw2, pw3;
                pw0.x = pk2(s[0], s[1]); pw0.y = pk2(s[2], s[3]); pw0.z = pk2(s[4], s[5]); pw0.w = pk2(s[6], s[7]);
                pw1.x = pk2(s[8], s[9]); pw1.y = pk2(s[10], s[11]); pw1.z = pk2(s[12], s[13]); pw1.w = pk2(s[14], s[15]);
                pw2.x = pk2(t[0], t[1]); pw2.y = pk2(t[2], t[3]); pw2.z = pk2(t[4], t[5]); pw2.w = pk2(t[6], t[7]);
                pw3.x = pk2(t[8], t[9]); pw3.y = pk2(t[10], t[11]); pw3.z = pk2(t[12], t[13]); pw3.w = pk2(t[14], t[15]);
                const bf16x8 pa0 = __builtin_bit_cast(bf16x8, pw0), pa1 = __builtin_bit_cast(bf16x8, pw1), pa2 = __builtin_bit_cast(bf16x8, pw2), pa3 = __builtin_bit_cast(bf16x8, pw3);
                o0 = __builtin_amdgcn_mfma_f32_32x32x16_bf16(pa0, v00, o0, 0, 0, 0);
                o1 = __builtin_amdgcn_mfma_f32_32x32x16_bf16(pa0, v10, o1, 0, 0, 0);
                o0 = __builtin_amdgcn_mfma_f32_32x32x16_bf16(pa1, v01, o0, 0, 0, 0);
                o1 = __builtin_amdgcn_mfma_f32_32x32x16_bf16(pa1, v11, o1, 0, 0, 0);
                o0 = __builtin_amdgcn_mfma_f32_32x32x16_bf16(pa2, v02, o0, 0, 0, 0);
                o1 = __builtin_amdgcn_mfma_f32_32x32x16_bf16(pa2, v12, o1, 0, 0, 0);
                o0 = __builtin_amdgcn_mfma_f32_32x32x16_bf16(pa3, v03, o0, 0, 0, 0);
                o1 = __builtin_amdgcn_mfma_f32_32x32x16_bf16(pa3, v13, o1, 0, 0, 0);
            }
        }
        }
        if (cb + nch == it.c1) {
            float lt; { const auto rr = __builtin_amdgcn_permlane32_swap(__float_as_uint(lrun), __float_as_uint(lrun), false, false); lt = __uint_as_float(rr[0]) + __uint_as_float(rr[1]); }
            float scale, L2 = 0.f;
            if (it.type == 4) { const float sink2 = a.sinks[layer * 6 + it.h] * LOG2E, mf = fmaxf(mrun, sink2), al = ex2(mrun - mf); scale = al / (lt * al + ex2(sink2 - mf)); }
            else { scale = 1.f / lt; L2 = mrun + log2f(lt); }
            if (hi == 0) { wsf[l31] = scale; wsf[32 + l31] = L2; }
#pragma unroll
            for (int g4 = 0; g4 < 4; ++g4) { const f32x4 av = *(LAS const f32x4*)(wsf + 8 * g4 + 4 * hi);
#pragma unroll
                for (int e = 0; e < 4; ++e) { const int r = 4 * g4 + e, row = 8 * g4 + 4 * hi + e;
                    stg[row * 72 + l31] = (bf16_t)f2bf(o0[r] * av[e]); stg[row * 72 + 32 + l31] = (bf16_t)f2bf(o1[r] * av[e]); } }
#pragma unroll
            for (int i = 0; i < 4; ++i) {
                const int row = i * 8 + (lane >> 3), ch = lane & 7;
                const u32x4 ov = *(LAS const u32x4*)(stg + row * 72 + ch * 8);
                const size_t tok = (size_t)(it.b * SEQ + (mq0 + row) * it.dil + qres);
                bf16_t* yp = Y + tok * 1024 + it.ycol + ch * 8;
                float f[8] = {bflo(ov.x), bfhi(ov.x), bflo(ov.y), bfhi(ov.y), bflo(ov.z), bfhi(ov.z), bflo(ov.w), bfhi(ov.w)};
                if (it.type == 1) { if (ch == 0) LSE[tok * 6 + it.h] = wsf[32 + row]; }
                if (it.type == 2 || it.type == 3) {
                    const u32x4 od = *(const u32x4*)yp; const float Lold = LSE[tok * 6 + it.h], Lnew = wsf[32 + row], Lm = fmaxf(Lold, Lnew);
                    float wo = ex2(Lold - Lm), wn = ex2(Lnew - Lm); const float sw = wo + wn, inv = 1.f / sw; wo *= inv; wn *= inv;
                    const float q[8] = {bflo(od.x), bfhi(od.x), bflo(od.y), bfhi(od.y), bflo(od.z), bfhi(od.z), bflo(od.w), bfhi(od.w)};
#pragma unroll
                    for (int e = 0; e < 8; ++e) f[e] = wo * q[e] + wn * f[e];
                    if (it.type == 2 && ch == 0) LSE[tok * 6 + it.h] = Lm + log2f(sw);
                }
                if (it.type == 0 || it.type >= 3) {
                    const u32x4 zv = *(const u32x4*)(QKVZ + tok * NQ + it.zcol + ch * 8);
                    const float z[8] = {bflo(zv.x), bfhi(zv.x), bflo(zv.y), bfhi(zv.y), bflo(zv.z), bfhi(zv.z), bflo(zv.w), bfhi(zv.w)};
#pragma unroll
                    for (int e = 0; e < 8; ++e) f[e] *= z[e];
                }
                u32x4 wv; wv.x = pk2(f[0], f[1]); wv.y = pk2(f[2], f[3]); wv.z = pk2(f[4], f[5]); wv.w = pk2(f[6], f[7]);
                *(u32x4*)yp = wv;
            }
        }
        if (!has_next) break;
        cb = ncb; j = nj;
    }
#undef ATT_ISSUE
}
}

__device__ __forceinline__ void final_norm_phase(const Args& a, int vcu, int G) {
    int tid_ = threadIdx.x; asm volatile("" : "+v"(tid_));
    const int tid = tid_, lane = tid & 63, wave = tid >> 6, gw = vcu * 8 + wave, NGW = G * 8;
    f32x4 gv[4];
#pragma unroll
    for (int j = 0; j < 4; ++j) gv[j] = *(const f32x4*)(a.final_g + 256 * j + 4 * lane);
    for (int m = gw; m < M; m += NGW) {
        f32x4* xr = (f32x4*)(a.out + (size_t)m * D) + lane;
        f32x4 v[4]; float s2 = 0.f;
#pragma unroll
        for (int j = 0; j < 4; ++j) { v[j] = xr[64 * j]; s2 += (v[j].x * v[j].x + v[j].y * v[j].y) + (v[j].z * v[j].z + v[j].w * v[j].w); }
        const float rs = 1.0f / sqrtf(wave_sum(s2, lane) * (1.f / D) + RMS_EPS);
#pragma unroll
        for (int j = 0; j < 4; ++j) xr[64 * j] = v[j] * rs * gv[j];
    }
}


#define XB_TMO      128
#define XB_XCNT(j)  (256  + 64 * (j))
#define XB_XSUB(j)  (1280 + 64 * (j))
#define XB_XGEN(j)  (2304 + 64 * (j))
#define XB_TOP      3328
#define XB_TOPGEN   3392
#define XCD_BAR_WORDS 3456
#define XB_SPIN_CAP (1u << 18)
__device__ __forceinline__ unsigned xb_ld(unsigned* p)              { return __hip_atomic_load(p, __ATOMIC_RELAXED, __HIP_MEMORY_SCOPE_AGENT); }
__device__ __forceinline__ unsigned xb_add(unsigned* p, unsigned v) { return __hip_atomic_fetch_add(p, v, __ATOMIC_RELAXED, __HIP_MEMORY_SCOPE_AGENT); }
__device__ __forceinline__ unsigned xb_xcc_id() { return (unsigned)__builtin_amdgcn_s_getreg((3 << 11) | 20) & 0xFu; }
#define XB_SPIN(cond, bar) do { unsigned _sp = 0; while (cond) { __builtin_amdgcn_s_sleep(1); \
    if ((++_sp & 255u) == 0u) { if (xb_ld(&(bar)[XB_TMO])) break; if (_sp > XB_SPIN_CAP) { atomicAdd(&(bar)[XB_TMO], 1u); break; } } } } while (0)
struct XcdBarrier { unsigned* bar; unsigned x; volatile LAS unsigned* st; };
__device__ __forceinline__ XcdBarrier xcd_barrier_post(unsigned* bar, volatile LAS unsigned* st) {
    XcdBarrier b; b.bar = bar; b.x = xb_xcc_id(); b.st = st;
    if (threadIdx.x == 0) (void)xb_add(&bar[XB_XCNT(b.x)], 1u);
    return b;
}
__device__ __forceinline__ void xcd_barrier_complete(unsigned* bar, unsigned x, unsigned& nloc, unsigned& nx) {
    const unsigned G = gridDim.x * gridDim.y * gridDim.z;
    unsigned sum, cnt, mine, sp = 0u;
    for (;;) {
        sum = 0u; cnt = 0u; mine = 0u;
#pragma unroll
        for (unsigned j = 0; j < 16; ++j) { const unsigned c = xb_ld(&bar[XB_XCNT(j)]); sum += c; cnt += (c > 0u) ? 1u : 0u; mine = (j == x) ? c : mine; }
        if (sum == G) break;
        __builtin_amdgcn_s_sleep(1);
        if ((++sp & 255u) == 0u) { if (xb_ld(&bar[XB_TMO])) break; if (sp > XB_SPIN_CAP) { atomicAdd(&bar[XB_TMO], 1u); break; } }
    }
    nloc = mine > 0u ? mine : 1u; nx = cnt > 0u ? cnt : 1u;
}
__device__ __forceinline__ void xcd_barrier(const XcdBarrier& b) {
    asm volatile("s_waitcnt vmcnt(0)" ::: "memory");
    __syncthreads();
    if (threadIdx.x == 0) {
        unsigned* bar = b.bar;
        __builtin_amdgcn_s_waitcnt(0);
        unsigned nloc = b.st[0], nx = b.st[1];
        if (nloc == 0u) { xcd_barrier_complete(bar, b.x, nloc, nx); b.st[0] = nloc; b.st[1] = nx; }
        const unsigned old = xb_add(&bar[XB_XSUB(b.x)], 1u);
        const unsigned gen = old / nloc;
        if (old + 1u == (gen + 1u) * nloc) {
            __builtin_amdgcn_fence(__ATOMIC_RELEASE, "agent");
            asm volatile("s_waitcnt vmcnt(0)" ::: "memory");
            const unsigned og = xb_add(&bar[XB_TOP], 1u);
            const unsigned tg = og / nx;
            if (og + 1u == (tg + 1u) * nx) xb_add(&bar[XB_TOPGEN], 1u);
            else XB_SPIN(xb_ld(&bar[XB_TOPGEN]) == tg, bar);
            __builtin_amdgcn_fence(__ATOMIC_ACQUIRE, "agent");
            xb_add(&bar[XB_XGEN(b.x)], 1u);
            asm volatile("s_waitcnt vmcnt(0)" ::: "memory");
        } else {
            XB_SPIN(xb_ld(&bar[XB_XGEN(b.x)]) == gen, bar);
            __builtin_amdgcn_fence(__ATOMIC_ACQUIRE, "agent");
            asm volatile("s_waitcnt vmcnt(0)" ::: "memory");
        }
    }
    __syncthreads();
}

__global__ void __launch_bounds__(NTHREADS, 2) fwd_megakernel(Args a) {
    extern __shared__ __attribute__((aligned(16))) unsigned char lds_raw[];
    cg::grid_group grid = cg::this_grid();
    LAS unsigned char* lds = (LAS unsigned char*)lds_raw;
    const int G = gridDim.x, bx = blockIdx.x;
    const int vcu = (G % 8 == 0) ? (bx % 8) * (G / 8) + bx / 8 : bx;
    unsigned char* ws = a.ws;
    if (ws == nullptr) grid.sync();
    volatile LAS unsigned* bst = (volatile LAS unsigned*)(lds + LDS_BYTES - 64);
    if (threadIdx.x < 2) bst[threadIdx.x] = 0u;
    __syncthreads();
    const XcdBarrier bar = xcd_barrier_post((unsigned*)ws, bst);
#pragma unroll 1
    for (int step = 0; step < 14; ++step) {
        const int layer = step / 7, ph = step - 7 * layer;
#ifndef NO_PREP
        if (ph == 0) { for (int rep = 0; rep < PROBE_REP_PREP; ++rep) prep_phase(a, layer, lds, vcu, G); }
        else
#endif
        if (ph == 1 || ph >= 5) {
#ifndef NO_GEMM
            if (ph == 1) cumsum_phase(a, bx);
            pg8::Sched S; S.kind = ph == 1 ? 0 : (ph == 5 ? 1 : 2); S.so.init(M, ph == 1 ? NP : 1024, G, bx);
            pg8::Epi E; E.QKVZ = (bf16_t*)(ws + WS_QKVZ); E.Gt = (bf16_t*)(ws + WS_G); E.MERGED = (bf16_t*)(ws + WS_QKVZ);
            E.xin = layer == 0 ? a.x : a.out; E.xout = a.out; E.cosT = (const float*)(ws + WS_COS); E.sinT = (const float*)(ws + WS_SIN);
            E.gfin = layer == 0 ? a.norm_g + D : a.final_g; E.Hout = (bf16_t*)(ws + WS_H); E.slots = (unsigned*)(ws + WS_SLOTS); E.cnt = (unsigned*)(ws + 16384 + layer * 32768); E.xl = lds + 131072;
            const bf16_t* A = ph == 1 ? (const bf16_t*)(ws + WS_H) : (ph == 5 ? (const bf16_t*)(ws + WS_H) : (const bf16_t*)(ws + WS_QKVZ));
            const bf16_t* Bt = ph == 1 ? (const bf16_t*)(ws + WS_WIN) : (ph == 5 ? (const bf16_t*)(ws + WS_WBR) : (const bf16_t*)(ws + WS_WOUT));
#ifdef ONLY_KIND
            pg8::gemm_phase<ONLY_KIND>(lds, A, Bt, S, E);
#else
            if (ph == 1) { for (int rep = 0; rep < PROBE_REP_GEMM1; ++rep) pg8::gemm_phase<0>(lds, A, Bt, S, E); } else if (ph == 5) { for (int rep = 0; rep < PROBE_REP_MERGE; ++rep) pg8::gemm_phase<1>(lds, A, Bt, S, E); } else if (layer == 0) pg8::gemm_phase<4>(lds, A, Bt, S, E); else pg8::gemm_phase<3>(lds, A, Bt, S, E);
#endif
#endif
        }
#ifndef NO_ATTN
        else { const int nrep = ph == 2 ? PROBE_REP_ATT0 : 1; for (int rep = 0; rep < nrep; ++rep) { attn::attn_phase(a, layer, ph - 2, lds, vcu); __syncthreads(); } }
#endif
        if (step == 13) break;
        xcd_barrier(bar);
#ifdef PROBE_SYNC2
        xcd_barrier(bar);
#endif
    }
}

extern "C" void kernel_launch(void* const* d_in, const int* in_sizes, int n_in, void* d_out, int out_size, void* d_ws, size_t ws_size, hipStream_t stream) {
    static int grid = 0;
    if (grid == 0) {
        if (n_in != 10 || in_sizes[0] != M * D || out_size != M * D || ws_size < WS_END) { fprintf(stderr, "kernel_launch: unexpected shapes/workspace (n_in %d, in0 %d, out %d, ws %zu)\n", n_in, n_in > 0 ? in_sizes[0] : -1, out_size, ws_size); grid = -1; return; }
        int dev = 0, cus = 0, per_cu = 0;
        if (hipGetDevice(&dev) != hipSuccess || hipDeviceGetAttribute(&cus, hipDeviceAttributeMultiprocessorCount, dev) != hipSuccess) { grid = -1; return; }
        if (hipFuncSetAttribute((const void*)fwd_megakernel, hipFuncAttributeMaxDynamicSharedMemorySize, LDS_BYTES) != hipSuccess) { fprintf(stderr, "kernel_launch: hipFuncSetAttribute failed\n"); grid = -1; return; }
        if (hipOccupancyMaxActiveBlocksPerMultiprocessor(&per_cu, (const void*)fwd_megakernel, NTHREADS, LDS_BYTES) != hipSuccess || per_cu < 1) { fprintf(stderr, "kernel_launch: occupancy query gave %d\n", per_cu); (void)hipGetLastError(); per_cu = 1; }
        grid = cus * (per_cu > 1 ? 1 : per_cu);
    }
    if (grid < 0) return;
    if (hipMemsetAsync(d_ws, 0, 131072, stream) != hipSuccess) { fprintf(stderr, "kernel_launch: memset of barrier words failed\n"); return; }
    Args a{};
    a.x = (const float*)d_in[0]; a.norm_g = (const float*)d_in[1]; a.w_in = (const float*)d_in[2]; a.b_forget = (const float*)d_in[3]; a.sinks = (const float*)d_in[4];
    a.w_br_a = (const float*)d_in[5]; a.w_br_b = (const float*)d_in[6]; a.w_br_c = (const float*)d_in[7]; a.w_out = (const float*)d_in[8]; a.final_g = (const float*)d_in[9];
    a.out = (float*)d_out; a.ws = (unsigned char*)d_ws;
    for (int i = 0; i < 32; ++i) a.inv_freq[i] = powf(10000.0f, -(float)(2 * i) / 64.0f);
    void* args[] = {&a};
    hipError_t e = hipLaunchCooperativeKernel((const void*)fwd_megakernel, dim3(grid), dim3(NTHREADS), args, LDS_BYTES, stream);
    if (e != hipSuccess) fprintf(stderr, "kernel_launch: cooperative launch failed: %s (grid %d)\n", hipGetErrorString(e), grid);
}
```
